# Optimizing an MI355X kernel written in HIP

```python
import jax, jax.numpy as jnp
from jax import lax
import numpy as np

D_MODEL = 2048
BATCH = 4
SEQ = 8192
DEPTH = 4
DEC_BATCH = 8
DEC_SEQ = 4096
PAST_LEN = 128

N_META = 16
D_FF = 4 * D_MODEL
NORM_EPS = 1e-6
ROPE_BASE = 10000.0
N_RET_LAYERS = (DEPTH + 1) // 2
N_MLA_LAYERS = DEPTH // 2
RET_HEADS = 8
RET_DK = 256
RET_DV = 512
RET_CHUNK = 128
MLA_HEADS = 16
MLA_Q_LORA = 512
MLA_KV_LORA = 512
MLA_NOPE = 128
MLA_ROPE = 64
MLA_V = 128
MLA_QBLOCK = 128

kernel_name = "hybrid_retention_mla_encoder"


def rms_norm(x, g):
    xf = x.astype(jnp.float32)
    y = xf * lax.rsqrt(jnp.mean(xf * xf, axis=-1, keepdims=True) + NORM_EPS)
    return (y * g.astype(jnp.float32)).astype(x.dtype)


def rope_tables(n, dim):
    inv = 1.0 / (ROPE_BASE ** (jnp.arange(0, dim, 2, dtype=jnp.float32) / dim))
    ang = jnp.arange(n, dtype=jnp.float32)[:, None] * inv[None, :]
    return jnp.cos(ang), jnp.sin(ang)


def apply_rope(x, cos, sin):
    half = x.shape[-1] // 2
    x1, x2 = x[..., :half], x[..., half:]
    c = cos[None, :, None, :].astype(x.dtype)
    s = sin[None, :, None, :].astype(x.dtype)
    return jnp.concatenate([x1 * c - x2 * s, x1 * s + x2 * c], axis=-1)


def retention_decays(log_g, backward):
    i = jnp.arange(RET_CHUNK, dtype=jnp.float32)
    diff = i[:, None] - i[None, :]
    lg = log_g[:, None, None]
    pw = jnp.exp(lg * jnp.abs(diff)[None])
    if backward:
        intra = jnp.where(diff[None] < 0, pw, 0.0)
        q_dec = jnp.exp(log_g[:, None] * (RET_CHUNK - i)[None])
        k_dec = jnp.exp(log_g[:, None] * i[None])
    else:
        intra = jnp.where(diff[None] >= 0, pw, 0.0)
        q_dec = jnp.exp(log_g[:, None] * (i + 1.0)[None])
        k_dec = jnp.exp(log_g[:, None] * (RET_CHUNK - 1.0 - i)[None])
    c_dec = jnp.exp(log_g * RET_CHUNK)
    return intra, q_dec, k_dec, c_dec


def retention(h, cos, sin, wq, wk, wv, wg, wo):
    B, L, _ = h.shape
    q = apply_rope((h @ wq).reshape(B, L, RET_HEADS, RET_DK), cos, sin)
    k = apply_rope((h @ wk).reshape(B, L, RET_HEADS, RET_DK), cos, sin) * (RET_DK ** -0.5)
    v = (h @ wv).reshape(B, L, RET_HEADS, RET_DV)
    pad = RET_CHUNK - N_META

    def to_chunks(t):
        t = jnp.pad(t, ((0, 0), (pad, 0), (0, 0), (0, 0)))
        n_c = t.shape[1] // RET_CHUNK
        t = t.reshape(B, n_c, RET_CHUNK, RET_HEADS, t.shape[-1])
        return jnp.transpose(t, (1, 0, 3, 2, 4))

    qc, kc, vc = to_chunks(q), to_chunks(k), to_chunks(v)
    hh = jnp.arange(RET_HEADS, dtype=jnp.float32)
    log_g_fwd = jnp.log(1.0 - 2.0 ** (-5.0 - hh))
    log_g_bwd = jnp.log(1.0 - 2.0 ** (-5.5 - hh))
    D_f, qd_f, kd_f, cd_f = retention_decays(log_g_fwd, backward=False)
    D_b, qd_b, kd_b, cd_b = retention_decays(log_g_bwd, backward=True)

    def make_step(D, qd, kd, cd):
        def step(R, xs):
            q_, k_, v_ = xs
            s = jnp.einsum('bhid,bhjd->bhij', q_, k_) * D[None]
            o = (jnp.einsum('bhij,bhjv->bhiv', s, v_)
                 + jnp.einsum('bhid,bhdv->bhiv', q_ * qd[None, :, :, None], R))
            R = cd[None, :, None, None] * R + jnp.einsum('bhjd,bhjv->bhdv', k_ * kd[None, :, :, None], v_)
            return R, o
        return step

    R0 = jnp.zeros((B, RET_HEADS, RET_DK, RET_DV), jnp.float32)
    _, o_f = lax.scan(make_step(D_f, qd_f, kd_f, cd_f), R0, (qc, kc, vc))
    _, o_b = lax.scan(make_step(D_b, qd_b, kd_b, cd_b), R0, (qc, kc, vc), reverse=True)
    o = jnp.transpose(o_f + o_b, (1, 0, 3, 2, 4))
    o = o.reshape(B, -1, RET_HEADS, RET_DV)[:, pad:].astype(jnp.float32)
    mu = jnp.mean(o, axis=-1, keepdims=True)
    var = jnp.mean(jnp.square(o - mu), axis=-1, keepdims=True)
    o = ((o - mu) * lax.rsqrt(var + NORM_EPS)).astype(h.dtype).reshape(B, L, RET_HEADS * RET_DV)
    return (jax.nn.silu(h @ wg) * o) @ wo


def mla(h, cos, sin, wq_a, q_norm, wq_b, wkv_a, kv_norm, wkv_b, wo):
    B, L, _ = h.shape
    cq = rms_norm(h @ wq_a, q_norm)
    q = (cq @ wq_b).reshape(B, L, MLA_HEADS, MLA_NOPE + MLA_ROPE)
    q_nope = q[..., :MLA_NOPE]
    q_rope = apply_rope(q[..., MLA_NOPE:], cos, sin)
    kv_a = h @ wkv_a
    ckv = rms_norm(kv_a[..., :MLA_KV_LORA], kv_norm)
    k_rope = apply_rope(kv_a[..., None, MLA_KV_LORA:], cos, sin)[:, :, 0]
    kv = (ckv @ wkv_b).reshape(B, L, MLA_HEADS, MLA_NOPE + MLA_V)
    k_nope, v = kv[..., :MLA_NOPE], kv[..., MLA_NOPE:]
    scale = (MLA_NOPE + MLA_ROPE) ** -0.5

    def attend(qn, qr):
        s = (jnp.einsum('bqhd,bkhd->bhqk', qn, k_nope)
             + jnp.einsum('bqhd,bkd->bhqk', qr, k_rope))
        p = jax.nn.softmax(s.astype(jnp.float32) * scale, axis=-1)
        return jnp.einsum('bhqk,bkhd->bqhd', p.astype(v.dtype), v)

    o_meta = attend(q_nope[:, :N_META], q_rope[:, :N_META])
    n_real = L - N_META
    n_blk = n_real // MLA_QBLOCK

    def blocks(t):
        return jnp.moveaxis(t[:, N_META:].reshape(B, n_blk, MLA_QBLOCK, MLA_HEADS, t.shape[-1]), 1, 0)

    o_real = lax.map(lambda a: attend(a[0], a[1]), (blocks(q_nope), blocks(q_rope)))
    o_real = jnp.moveaxis(o_real, 0, 1).reshape(B, n_real, MLA_HEADS, MLA_V)
    o = jnp.concatenate([o_meta, o_real], axis=1).reshape(B, L, MLA_HEADS * MLA_V)
    return o @ wo


def sq_relu_mlp(h, w1, w2):
    return jnp.square(jax.nn.relu(h @ w1)) @ w2


def trunk(x, meta_tokens, norm1_g, norm2_g, mlp_w1, mlp_w2,
          ret_wq, ret_wk, ret_wv, ret_wg, ret_wo,
          mla_wq_a, mla_q_norm, mla_wq_b, mla_wkv_a, mla_kv_norm, mla_wkv_b, mla_wo,
          final_norm):
    B, S, D = x.shape
    meta = jnp.broadcast_to(meta_tokens.astype(x.dtype)[None], (B, N_META, D))
    h = jnp.concatenate([meta, x], axis=1)
    L = S + N_META
    cos_r, sin_r = rope_tables(L, RET_DK)
    cos_m, sin_m = rope_tables(L, MLA_ROPE)
    for i in range(DEPTH):
        a = rms_norm(h, norm1_g[i])
        j = i // 2
        if i % 2 == 0:
            h = h + retention(a, cos_r, sin_r, ret_wq[j], ret_wk[j], ret_wv[j], ret_wg[j], ret_wo[j])
        else:
            h = h + mla(a, cos_m, sin_m, mla_wq_a[j], mla_q_norm[j], mla_wq_b[j],
                        mla_wkv_a[j], mla_kv_norm[j], mla_wkv_b[j], mla_wo[j])
        a = rms_norm(h, norm2_g[i])
        h = h + sq_relu_mlp(a, mlp_w1[i], mlp_w2[i])
    return rms_norm(h, final_norm)[:, N_META:]


def setup_inputs(seed: int = 0) -> dict:
    key = jax.random.key(seed)
    ks = jax.random.split(key, 24)
    f32 = jnp.float32

    def w(k, shape, fan_in):
        return jax.random.normal(k, shape, f32) * (fan_in ** -0.5)

    def gain(k, shape):
        return 1.0 + 0.02 * jax.random.normal(k, shape, f32)

    D = D_MODEL
    NR, NM = N_RET_LAYERS, N_MLA_LAYERS
    return {
        "x_prompt": jax.random.normal(ks[0], (BATCH, SEQ, D), f32),
        "x_sample": jax.random.normal(ks[1], (DEC_BATCH, DEC_SEQ, D), f32),
        "meta_tokens": jax.random.normal(ks[2], (N_META, D), f32),
        "norm1_g": gain(ks[3], (DEPTH, D)),
        "norm2_g": gain(ks[4], (DEPTH, D)),
        "mlp_w1": w(ks[5], (DEPTH, D, D_FF), D),
        "mlp_w2": w(ks[6], (DEPTH, D_FF, D), D_FF),
        "ret_wq": w(ks[7], (NR, D, RET_HEADS * RET_DK), D),
        "ret_wk": w(ks[8], (NR, D, RET_HEADS * RET_DK), D),
        "ret_wv": w(ks[9], (NR, D, RET_HEADS * RET_DV), D),
        "ret_wg": w(ks[10], (NR, D, RET_HEADS * RET_DV), D),
        "ret_wo": w(ks[11], (NR, RET_HEADS * RET_DV, D), RET_HEADS * RET_DV),
        "mla_wq_a": w(ks[12], (NM, D, MLA_Q_LORA), D),
        "mla_q_norm": gain(ks[13], (NM, MLA_Q_LORA)),
        "mla_wq_b": w(ks[14], (NM, MLA_Q_LORA, MLA_HEADS * (MLA_NOPE + MLA_ROPE)), MLA_Q_LORA),
        "mla_wkv_a": w(ks[15], (NM, D, MLA_KV_LORA + MLA_ROPE), D),
        "mla_kv_norm": gain(ks[16], (NM, MLA_KV_LORA)),
        "mla_wkv_b": w(ks[17], (NM, MLA_KV_LORA, MLA_HEADS * (MLA_NOPE + MLA_V)), MLA_KV_LORA),
        "mla_wo": w(ks[18], (NM, MLA_HEADS * MLA_V, D), MLA_HEADS * MLA_V),
        "final_norm": gain(ks[19], (D,)),
    }


def reference(x_prompt, x_sample, meta_tokens, norm1_g, norm2_g, mlp_w1, mlp_w2,
              ret_wq, ret_wk, ret_wv, ret_wg, ret_wo,
              mla_wq_a, mla_q_norm, mla_wq_b, mla_wkv_a, mla_kv_norm, mla_wkv_b, mla_wo,
              final_norm):
    y_prompt = trunk(x_prompt, meta_tokens, norm1_g, norm2_g, mlp_w1, mlp_w2,
                     ret_wq, ret_wk, ret_wv, ret_wg, ret_wo,
                     mla_wq_a, mla_q_norm, mla_wq_b, mla_wkv_a, mla_kv_norm, mla_wkv_b, mla_wo,
                     final_norm)
    y_sample = trunk(x_sample, meta_tokens, norm1_g, norm2_g, mlp_w1, mlp_w2,
                     ret_wq, ret_wk, ret_wv, ret_wg, ret_wo,
                     mla_wq_a, mla_q_norm, mla_wq_b, mla_wkv_a, mla_kv_norm, mla_wkv_b, mla_wo,
                     final_norm)
    return (y_prompt, y_sample)
```

```cpp
#include <hip/hip_runtime.h>
#include <cstdio>
#include <cstdint>
#include <cmath>
#include <type_traits>

#ifndef MK_PER_PHASE_LAUNCH
#define MK_PER_PHASE_LAUNCH 0
#endif
#ifndef EN_SCAN
#define EN_SCAN 1
#endif
#ifndef EN_ATTN
#define EN_ATTN 1
#endif
#ifndef EN_MISC
#define EN_MISC 1
#endif
#ifndef EN_G1
#define EN_G1 1
#endif
#ifndef EN_G2
#define EN_G2 1
#endif
#ifndef EN_G3
#define EN_G3 1
#endif
#ifndef EN_G4
#define EN_G4 1
#endif
#ifndef EN_PREP
#define EN_PREP 1
#endif
#ifndef EN_M1
#define EN_M1 1
#endif
#ifndef EN_M2
#define EN_M2 1
#endif
#ifndef REP_GEMM
#define REP_GEMM 1
#endif
#ifndef REP_ATTN
#define REP_ATTN 1
#endif
#ifndef REP_SCAN
#define REP_SCAN 1
#endif
#ifndef REP_MISC
#define REP_MISC 1
#endif
#ifndef MK_DEBUG_CHECK
#define MK_DEBUG_CHECK 0
#endif

constexpr int D = 2048, FF = 8192, DEPTH = 4;
constexpr int PADF = 112, NMETA = 16;
constexpr int NP = 4, NS = 8, SP = 8192, SS = 4096;
constexpr int LP_P = PADF + NMETA + SP  , LP_S = PADF + NMETA + SS  ;
constexpr int ROWS0 = NP * LP_P  , ROWS1 = NS * LP_S  , MT = ROWS0 + ROWS1  ;
constexpr int LMAX = NMETA + SP;
constexpr float NORM_EPS = 1e-6f;
constexpr int RH = 8, RDK = 256, RDV = 512;
constexpr int MH = 16, MQL = 512, MKVL = 512, MNOPE = 128, MROPE = 64, MV = 128, MQK = MNOPE + MROPE;
constexpr int FFA = 4352, FFB = FF - FFA;
static_assert(ROWS0 % 256 == 0 && ROWS1 % 256 == 0, "halves are whole 256-row tiles");

constexpr size_t MiB = 1u << 20;
constexpr size_t WS_CTL = 0, CTL_ZERO_BYTES = 65536;
constexpr size_t TAB_COSR = 1 * MiB, TAB_R_BYTES = (size_t)LMAX * 128 * 4, TAB_SINR = TAB_COSR + TAB_R_BYTES;
constexpr size_t TAB_COSM = TAB_SINR + TAB_R_BYTES, TAB_M_BYTES = (size_t)LMAX * 32 * 4, TAB_SINM = TAB_COSM + TAB_M_BYTES;
constexpr size_t WS_RSTD = 12 * MiB;
static_assert(TAB_SINM + TAB_M_BYTES <= WS_RSTD && WS_RSTD + (size_t)MT * 4 <= 13 * MiB, "tables");
constexpr size_t WS_H = 13 * MiB;
constexpr size_t WS_A = WS_H + 262 * MiB;
constexpr size_t WS_W = WS_A + 262 * MiB;
constexpr size_t WS_S = WS_W + 128 * MiB;
constexpr size_t WS_NEED = WS_S + 660 * MiB;
static_assert((size_t)MT * D * 2 == 262 * MiB, "h size");
constexpr size_t W_RQKV = 0, W_RG = 32 * MiB, W_RO = 48 * MiB;
constexpr size_t W_MA = 0, W_MQB = 5 * MiB, W_MKVB = 8 * MiB, W_MO = 12 * MiB;
constexpr size_t W_1 = 64 * MiB, W_2 = 96 * MiB;
constexpr size_t S_RV = 0, S_ROF = 264 * MiB, S_RK = 528 * MiB;
constexpr size_t O_ROB = 0, O_RQ = 264 * MiB, O_RP = 396 * MiB;
static_assert(O_RP + (size_t)(ROWS1 / 128) * RH * 32768 <= 512 * MiB, "P buffer");
constexpr size_t S_MQ = 0, S_MKN = 393 * MiB;
constexpr size_t O_MV = 0, O_MKR = 262 * MiB, O_MCQKV = 271 * MiB;
constexpr size_t X_MCN = 0, X_MO = 0;
static_assert(S_MKN + 262 * MiB <= 692 * MiB && O_MCQKV + (size_t)MT * 1280 * 2 <= 512 * MiB, "MLA buffers");
constexpr size_t S_HID = 0, O_HID = 0;
static_assert((size_t)MT * FFA * 2 <= 692 * MiB && (size_t)MT * FFB * 2 <= 512 * MiB && FFA % 256 == 0 && FFB % 256 == 0 && FFA % 128 == 0, "hidden parts fit");
constexpr int MA_N = 1280;

constexpr int RING_BYTES = 131072;
constexpr int LDS_BYTES = 147456;
constexpr int MISC_OFF = LDS_BYTES - 256;
constexpr int ARGS_OFF = LDS_BYTES - 1280;

#define GAS __attribute__((address_space(1)))
#define LAS __attribute__((address_space(3)))
typedef unsigned short bf16_t;
typedef short bf16x8 __attribute__((ext_vector_type(8)));
typedef short s16x4 __attribute__((ext_vector_type(4)));
typedef float f32x4 __attribute__((ext_vector_type(4)));
typedef float f32x16 __attribute__((ext_vector_type(16)));
typedef unsigned u32x4 __attribute__((ext_vector_type(4)));
typedef unsigned u32x2 __attribute__((ext_vector_type(2)));
typedef GAS unsigned gu32;

__device__ __forceinline__ unsigned cvt_pk_bf16(float lo, float hi) { unsigned r; asm volatile("v_cvt_pk_bf16_f32 %0, %1, %2" : "=v"(r) : "v"(lo), "v"(hi)); return r; }
__device__ __forceinline__ float bf_lo(unsigned w) { return __uint_as_float(w << 16); }
__device__ __forceinline__ float bf_hi(unsigned w) { return __uint_as_float(w & 0xffff0000u); }
__device__ __forceinline__ float bf2f(bf16_t b) { return __uint_as_float((unsigned)b << 16); }
template <int X> __device__ __forceinline__ float swz_xor(float v) { return __int_as_float(__builtin_amdgcn_ds_swizzle(__float_as_int(v), 0x1F | (X << 10))); }
__device__ __forceinline__ float wave_sum(float v) {
    v += swz_xor<1>(v); v += swz_xor<2>(v); v += swz_xor<4>(v); v += swz_xor<8>(v); v += swz_xor<16>(v);
    const auto rr = __builtin_amdgcn_permlane32_swap(__float_as_uint(v), __float_as_uint(v), false, false);
    return __uint_as_float(rr[0]) + __uint_as_float(rr[1]);
}
__device__ __forceinline__ int row_tpos(int grow) { const int rs = grow < ROWS0 ? grow % LP_P : (grow - ROWS0) % LP_S; return rs - PADF; }

namespace pg8 {
#define PG8_LAS __attribute__((address_space(3)))
constexpr int BM = 256, BK = 64, HALF = 128, HTB = HALF * BK * 2, STAGE_BYTES = 8 * HTB, NXCD = 8, WGM = 8;
__host__ __device__ __forceinline__ int lds_byte(int r, int c) { const int st = (r >> 4) * 2 + (c >> 5), rr = r & 15, cc = c & 31, ob = rr * 64 + cc * 2; return st * 1024 + (ob ^ (((ob >> 9) & 1) << 5)); }
__host__ __device__ __forceinline__ void stage_rc(int b, int& R, int& C) { const int st = b / 1024, sb = b % 1024, swz = sb ^ (((sb >> 9) & 1) << 5); R = (st >> 1) * 16 + swz / 64; C = (st & 1) * 32 + (swz % 64) / 2; }
__host__ __device__ __forceinline__ int perm32(int rho) { const int n = rho >> 4, i = rho & 15; return 8 * (i >> 2) + 4 * n + (i & 3); }
#ifndef WGM_SEL
#define WGM_SEL(nN) ((nN) >= 32 ? 8 : 4)
#endif
struct Unit { int pm, pn; };
struct Gemm { const bf16_t* A; const bf16_t* Bt; int M, N, K, lda, ldb; };
struct StaticOrder {
    int nM, nN, nwg, G, c, wgm;
    __host__ __device__ void init(int M, int N, int G_, int c_) { nM = M / BM; nN = N / BM; nwg = nM * nN; G = G_; c = c_; wgm = WGM_SEL(nN); }
    __host__ __device__ bool next(int i, Unit& u) const {
        const long L = (long)i * G + c; if (L >= nwg) return false;
        int wgid = (int)L; { const int q = nwg / NXCD, r = nwg % NXCD, xcd = wgid % NXCD, off = wgid / NXCD; wgid = (xcd < r ? xcd * (q + 1) : r * (q + 1) + (xcd - r) * q) + off; }
        const int nig = wgm * nN, gid = wgid / nig, fm = gid * wgm, gsz = (nM - fm) < wgm ? (nM - fm) : wgm;
        u.pm = fm + ((wgid % nig) % gsz); u.pn = (wgid % nig) / gsz; return true;
    }
    __device__ __forceinline__ void a_ready(const Unit&) const {}
    __device__ __forceinline__ void done(const Unit&) const {}
};

struct UpBOrder {
    StaticOrder S;
    __host__ __device__ void init(int M, int N, int G_, int c_) { S.init(M, N, G_, c_); }
    __host__ __device__ bool next(int i, Unit& u) const {
        if (S.G != 256 || S.nwg != 3930) return S.next(i, u);
        long L;
        if (i < 14) L = (long)i * 256 + S.c; else if (i == 14) { if (S.c < 48) return false; L = 3584 + (S.c - 48); } else if (i == 15) { if (S.c < 48 || S.c >= 186) return false; L = 3792 + (S.c - 48); } else return false;
        StaticOrder T = S; T.G = 1; T.c = 0; return T.next((int)L, u);
    }
    __device__ __forceinline__ void a_ready(const Unit&) const {}
    __device__ __forceinline__ void done(const Unit&) const {}
};

template <int ACT  > struct EpiStore {
    static constexpr bool PERM = true, AFTER_DRAIN = false;
    bf16_t* O; int ldc; int split_cols; bf16_t* O2; const float* rs;
    __device__ __forceinline__ void operator()(const f32x4 (&acc)[2][2][4][2], const Unit& u, int wr, int wc, int fr, int fq) const {
        const int row0 = u.pm * BM + wr * 64 + fr; int colt = u.pn * BM; bf16_t* base = O;
        if (split_cols && colt >= split_cols) { base = O2; colt -= split_cols; }
        const int col0 = colt + wc * 32 + 8 * fq;
        float rsv[2][4];
#pragma unroll
        for (int ai = 0; ai < 2; ++ai)
#pragma unroll
            for (int m = 0; m < 4; ++m) rsv[ai][m] = rs ? rs[row0 + ai * HALF + m * 16] : 1.f;
#pragma unroll
        for (int ai = 0; ai < 2; ++ai)
#pragma unroll
            for (int m = 0; m < 4; ++m) { bf16_t* rowp = base + (size_t)(row0 + ai * HALF + m * 16) * ldc + col0;
                const float rsc = rsv[ai][m];
#pragma unroll
                for (int bj = 0; bj < 2; ++bj) { f32x4 v0 = acc[ai][bj][m][0] * rsc, v1 = acc[ai][bj][m][1] * rsc;
                    if (ACT == 1) {
#pragma unroll
                        for (int e = 0; e < 4; ++e) { const float a = fmaxf(v0[e], 0.f), b = fmaxf(v1[e], 0.f); v0[e] = a * a; v1[e] = b * b; } }
                    u32x4 w; w.x = cvt_pk_bf16(v0[0], v0[1]); w.y = cvt_pk_bf16(v0[2], v0[3]); w.z = cvt_pk_bf16(v1[0], v1[1]); w.w = cvt_pk_bf16(v1[2], v1[3]);
                    *(u32x4*)(rowp + bj * HALF) = w; } }
    }
};
struct EpiRes {
    static constexpr bool PERM = true, AFTER_DRAIN = false;
    bf16_t* H; int ldc; int dry;
    __device__ __forceinline__ void operator()(const f32x4 (&acc)[2][2][4][2], const Unit& u, int wr, int wc, int fr, int fq) const {
        const int row0 = u.pm * BM + wr * 64 + fr; const int col0 = u.pn * BM + wc * 32 + 8 * fq;
        u32x4 ov[2][4][2];
#pragma unroll
        for (int ai = 0; ai < 2; ++ai)
#pragma unroll
            for (int m = 0; m < 4; ++m) { const bf16_t* rowp = H + (size_t)(row0 + ai * HALF + m * 16) * ldc + col0;
#pragma unroll
                for (int bj = 0; bj < 2; ++bj) ov[ai][m][bj] = *(const u32x4*)(rowp + bj * HALF); }
#pragma unroll
        for (int ai = 0; ai < 2; ++ai)
#pragma unroll
            for (int m = 0; m < 4; ++m) { bf16_t* rowp = H + (size_t)(row0 + ai * HALF + m * 16) * ldc + col0;
#pragma unroll
                for (int bj = 0; bj < 2; ++bj) { const f32x4 v0 = acc[ai][bj][m][0], v1 = acc[ai][bj][m][1];
                    const u32x4 o = ov[ai][m][bj]; u32x4 w;
                    w.x = cvt_pk_bf16(bf_lo(o.x) + v0[0], bf_hi(o.x) + v0[1]); w.y = cvt_pk_bf16(bf_lo(o.y) + v0[2], bf_hi(o.y) + v0[3]);
                    w.z = cvt_pk_bf16(bf_lo(o.z) + v1[0], bf_hi(o.z) + v1[1]); w.w = cvt_pk_bf16(bf_lo(o.w) + v1[2], bf_hi(o.w) + v1[3]);
                    if (!dry) *(u32x4*)(rowp + bj * HALF) = w; } }
    }
};
struct EpiRetQKV {
    static constexpr bool PERM = true, AFTER_DRAIN = false;
    bf16_t *Q, *K, *V; const float* cosT; const float* sinT; int grow0; const float* rs;
    __device__ __forceinline__ void operator()(const f32x4 (&acc)[2][2][4][2], const Unit& u, int wr, int wc, int fr, int fq) const {
        const int row0 = u.pm * BM + wr * 64 + fr;
        if (u.pn >= 16) {
            const int col0 = (u.pn - 16) * BM + wc * 32 + 8 * fq;
            float rsv[2][4];
#pragma unroll
            for (int ai = 0; ai < 2; ++ai)
#pragma unroll
                for (int m = 0; m < 4; ++m) rsv[ai][m] = rs[row0 + ai * HALF + m * 16];
#pragma unroll
            for (int ai = 0; ai < 2; ++ai)
#pragma unroll
                for (int m = 0; m < 4; ++m) { bf16_t* rowp = V + (size_t)(row0 + ai * HALF + m * 16) * 4096 + col0; const float rsc = rsv[ai][m];
#pragma unroll
                    for (int bj = 0; bj < 2; ++bj) { const f32x4 v0 = acc[ai][bj][m][0] * rsc, v1 = acc[ai][bj][m][1] * rsc;
                        u32x4 w; w.x = cvt_pk_bf16(v0[0], v0[1]); w.y = cvt_pk_bf16(v0[2], v0[3]); w.z = cvt_pk_bf16(v1[0], v1[1]); w.w = cvt_pk_bf16(v1[2], v1[3]);
                        *(u32x4*)(rowp + bj * HALF) = w; } }
        } else {
            bf16_t* T = (u.pn < 8) ? Q : K; const int head = u.pn & 7; const int j0 = wc * 32 + 8 * fq;
#pragma unroll
            for (int ab = 0; ab < 4; ++ab) { const int ai = ab >> 1, mb = (ab & 1) * 2;
                f32x4 c0v[4], c1v[4], s0v[4], s1v[4]; float rsv[4];
#pragma unroll
                for (int m = mb; m < mb + 2; ++m) { const int row = row0 + ai * HALF + m * 16; int t = row_tpos(grow0 + row); t = t < 0 ? 0 : t;
                    c0v[m] = *(const f32x4*)(cosT + (size_t)t * 128 + j0); c1v[m] = *(const f32x4*)(cosT + (size_t)t * 128 + j0 + 4);
                    s0v[m] = *(const f32x4*)(sinT + (size_t)t * 128 + j0); s1v[m] = *(const f32x4*)(sinT + (size_t)t * 128 + j0 + 4); rsv[m] = rs[row]; }
#pragma unroll
                for (int m = mb; m < mb + 2; ++m) { const int row = row0 + ai * HALF + m * 16;
                    const f32x4 c0 = c0v[m], c1 = c1v[m], s0 = s0v[m], s1 = s1v[m];
                    const float rsc = rsv[m]; const f32x4 a0 = acc[ai][0][m][0] * rsc, a1 = acc[ai][0][m][1] * rsc, b0 = acc[ai][1][m][0] * rsc, b1 = acc[ai][1][m][1] * rsc;
                    const f32x4 x0 = a0 * c0 - b0 * s0, x1 = a1 * c1 - b1 * s1, y0 = a0 * s0 + b0 * c0, y1 = a1 * s1 + b1 * c1;
                    bf16_t* rowp = T + (size_t)row * 2048 + head * 256 + j0;
                    u32x4 w; w.x = cvt_pk_bf16(x0[0], x0[1]); w.y = cvt_pk_bf16(x0[2], x0[3]); w.z = cvt_pk_bf16(x1[0], x1[1]); w.w = cvt_pk_bf16(x1[2], x1[3]);
                    *(u32x4*)(rowp) = w;
                    w.x = cvt_pk_bf16(y0[0], y0[1]); w.y = cvt_pk_bf16(y0[2], y0[3]); w.z = cvt_pk_bf16(y1[0], y1[1]); w.w = cvt_pk_bf16(y1[2], y1[3]);
                    *(u32x4*)(rowp + 128) = w; } }
        }
    }
};
struct EpiMlaQ {
    static constexpr bool PERM = true, AFTER_DRAIN = false;
    bf16_t* Q; const float* cosT; const float* sinT; int grow0;
    __device__ __forceinline__ void operator()(const f32x4 (&acc)[2][2][4][2], const Unit& u, int wr, int wc, int fr, int fq) const {
        const int row0 = u.pm * BM + wr * 64 + fr; const int col0 = u.pn * BM + wc * 32 + 8 * fq;
#pragma unroll
        for (int ai = 0; ai < 2; ++ai) {
            f32x4 cv[4][2], sv[4][2];
#pragma unroll
            for (int m = 0; m < 4; ++m) { const int row = row0 + ai * HALF + m * 16; int t = row_tpos(grow0 + row); t = t < 0 ? 0 : t;
#pragma unroll
                for (int bj = 0; bj < 2; ++bj) { const int col = col0 + bj * HALF, w192 = col % 192; cv[m][bj] = (f32x4){1.f, 1.f, 1.f, 1.f}; sv[m][bj] = (f32x4){0.f, 0.f, 0.f, 0.f};
                    if (w192 >= 128) { const int jj = (w192 - 128) >> 1; cv[m][bj] = *(const f32x4*)(cosT + (size_t)t * 32 + jj); sv[m][bj] = *(const f32x4*)(sinT + (size_t)t * 32 + jj); } } }
#pragma unroll
            for (int m = 0; m < 4; ++m) { const int row = row0 + ai * HALF + m * 16;
#pragma unroll
                for (int bj = 0; bj < 2; ++bj) { f32x4 v0 = acc[ai][bj][m][0], v1 = acc[ai][bj][m][1];
                    const int col = col0 + bj * HALF, w192 = col % 192;
                    if (w192 >= 128) {
                        const f32x4 c = cv[m][bj], s = sv[m][bj];
                        const f32x4 r0 = {v0[0] * c[0] - v0[1] * s[0], v0[0] * s[0] + v0[1] * c[0], v0[2] * c[1] - v0[3] * s[1], v0[2] * s[1] + v0[3] * c[1]};
                        const f32x4 r1 = {v1[0] * c[2] - v1[1] * s[2], v1[0] * s[2] + v1[1] * c[2], v1[2] * c[3] - v1[3] * s[3], v1[2] * s[3] + v1[3] * c[3]};
                        v0 = r0; v1 = r1; }
                    u32x4 w; w.x = cvt_pk_bf16(v0[0], v0[1]); w.y = cvt_pk_bf16(v0[2], v0[3]); w.z = cvt_pk_bf16(v1[0], v1[1]); w.w = cvt_pk_bf16(v1[2], v1[3]);
                    *(u32x4*)(Q + (size_t)row * 3072 + col) = w; } } }
    }
};

template <class Epi, class Sched, bool ALIGN_EPI = false, bool SP2 = false>
__device__ __forceinline__ void gemm_phase(PG8_LAS unsigned char* lds, const Gemm g, const Sched& S, const Epi& E, const int tid_in) {
    const int tid = tid_in, wid = __builtin_amdgcn_readfirstlane(tid >> 6), lane = tid & 63, wr = wid >> 2, wc = wid & 3, fr = lane & 15, fq = lane >> 4;
    const int K = g.K, nt = K / BK;
    unsigned voffA[2], voffB[2];
#pragma unroll
    for (int i = 0; i < 2; ++i) { int R, C; stage_rc(tid * 16 + i * 8192, R, C); const int Rb = Epi::PERM ? ((R & ~31) + perm32(R & 31)) : R;
        voffA[i] = (unsigned)(R * g.lda + C) * 2u; voffB[i] = (unsigned)(Rb * g.ldb + C) * 2u; }
    const size_t kstep = (size_t)(BK * 2);
    const size_t hstepA = (size_t)HALF * g.lda * 2, hstepB = (size_t)HALF * g.ldb * 2;
    const size_t tstepA = 2 * hstepA, tstepB = 2 * hstepB;
    const unsigned ldsw = (unsigned)wid * 1024u;
    const int aoff = lds_byte(wr * 64 + fr, fq * 8), boff = lds_byte(wc * 32 + fr, fq * 8);
#define PG8_SA(b, h) (((b) * 2 + (h)) * HTB)
#define PG8_SB(b, h) ((4 + (b) * 2 + (h)) * HTB)
#define PG8_STAGE(bufoff, gbase, voff) do { _Pragma("unroll") for (int _i = 0; _i < 2; ++_i) \
        __builtin_amdgcn_global_load_lds((const unsigned*)((const char*)(gbase) + (voff)[_i]), (PG8_LAS unsigned*)(lds + (bufoff) + ldsw + _i * 8192), 16, 0, 0); } while (0)
#define PG8_LDA(dst, b, h) do { _Pragma("unroll") for (int m = 0; m < 4; ++m) _Pragma("unroll") for (int k = 0; k < 2; ++k) dst[m][k] = *(const PG8_LAS bf16x8*)(lds + PG8_SA(b, h) + aoff + m * 2048 + k * 1024); } while (0)
#define PG8_LDB(dst, b, h) do { _Pragma("unroll") for (int n = 0; n < 2; ++n) _Pragma("unroll") for (int k = 0; k < 2; ++k) dst[n][k] = *(const PG8_LAS bf16x8*)(lds + PG8_SB(b, h) + boff + n * 2048 + k * 1024); } while (0)
#define PG8_MMA(ai, bj, At, Bt) do { __builtin_amdgcn_s_setprio(1); _Pragma("unroll") for (int m = 0; m < 4; ++m) _Pragma("unroll") for (int n = 0; n < 2; ++n) _Pragma("unroll") for (int k = 0; k < 2; ++k) \
        acc[ai][bj][m][n] = __builtin_amdgcn_mfma_f32_16x16x32_bf16(Bt[n][k], At[m][k], acc[ai][bj][m][n], 0, 0, 0); __builtin_amdgcn_s_setprio(0); } while (0)
#define PG8_WAIT_V(n) asm volatile("s_waitcnt vmcnt(" #n ")" ::: "memory")
#define PG8_WAIT_L(n) asm volatile("s_waitcnt lgkmcnt(" #n ")" ::: "memory")
#define PG8_BAR __builtin_amdgcn_s_barrier()
#define PG8_SCHED __builtin_amdgcn_sched_barrier(0)
    Unit cur, nxt; int ui = 0;
    if (!S.next(0, cur)) return;
    f32x4 acc[2][2][4][2];
#pragma unroll
    for (int a = 0; a < 2; ++a)
#pragma unroll
        for (int b = 0; b < 2; ++b)
#pragma unroll
            for (int m = 0; m < 4; ++m)
#pragma unroll
                for (int n = 0; n < 2; ++n) acc[a][b][m][n] = (f32x4){0.f, 0.f, 0.f, 0.f};
    bf16x8 At[4][2], B0[2][2], B1[2][2];
    const char* cA = (const char*)g.A + (size_t)cur.pm * tstepA; const char* cB = (const char*)g.Bt + (size_t)cur.pn * tstepB;
    S.a_ready(cur);
    if constexpr (SP2) {
        PG8_STAGE(PG8_SB(0, 0), cB, voffB); PG8_STAGE(PG8_SB(0, 1), cB + hstepB, voffB); PG8_STAGE(PG8_SA(0, 0), cA, voffA); PG8_STAGE(PG8_SA(0, 1), cA + hstepA, voffA);
        if (wr == 1) PG8_BAR;
        PG8_WAIT_V(2); PG8_BAR;
        PG8_STAGE(PG8_SB(1, 0), cB + kstep, voffB); PG8_STAGE(PG8_SA(1, 0), cA + kstep, voffA); PG8_STAGE(PG8_SB(1, 1), cB + hstepB + kstep, voffB);
        PG8_WAIT_V(6); PG8_BAR;
    } else {
        PG8_STAGE(PG8_SB(0, 0), cB, voffB); PG8_STAGE(PG8_SA(0, 0), cA, voffA); PG8_STAGE(PG8_SB(0, 1), cB + hstepB, voffB); PG8_STAGE(PG8_SA(0, 1), cA + hstepA, voffA);
        if (wr == 1) PG8_BAR;
        PG8_WAIT_V(4); PG8_BAR;
        PG8_STAGE(PG8_SB(1, 0), cB + kstep, voffB); PG8_STAGE(PG8_SA(1, 0), cA + kstep, voffA); PG8_STAGE(PG8_SB(1, 1), cB + hstepB + kstep, voffB);
        PG8_WAIT_V(6); PG8_BAR;
    }
    for (;;) {
        const bool has_next = S.next(ui + 1, nxt);
        const char* nA = has_next ? (const char*)g.A + (size_t)nxt.pm * tstepA : cA; const char* nB = has_next ? (const char*)g.Bt + (size_t)nxt.pn * tstepB : cB;
        for (int t = 0; t < nt; t += 2) {
            const bool last = (t == nt - 2);
            const char* a1 = cA + (size_t)(t + 1) * kstep;
            const char* a2 = last ? nA : cA + (size_t)(t + 2) * kstep; const char* b2 = last ? nB : cB + (size_t)(t + 2) * kstep;
            const char* a3 = a2 + kstep; const char* b3 = b2 + kstep;
            if (last && has_next) S.a_ready(nxt);
            if constexpr (SP2) {
            PG8_LDB(B0, 0, 0); PG8_LDB(B1, 0, 1); PG8_SCHED; PG8_LDA(At, 0, 0); PG8_STAGE(PG8_SA(1, 1), a1 + hstepA, voffA);
            PG8_WAIT_V(8); PG8_WAIT_L(0); PG8_BAR; PG8_MMA(0, 0, At, B0); PG8_MMA(0, 1, At, B1); PG8_BAR; PG8_SCHED;
            PG8_LDA(At, 0, 1); PG8_STAGE(PG8_SB(0, 0), b2, voffB); PG8_STAGE(PG8_SB(0, 1), b2 + hstepB, voffB); PG8_STAGE(PG8_SA(0, 0), a2, voffA);
            PG8_WAIT_V(8); PG8_WAIT_L(0); PG8_BAR; PG8_MMA(1, 0, At, B0); PG8_MMA(1, 1, At, B1); PG8_BAR; PG8_SCHED;
            PG8_LDB(B0, 1, 0); PG8_LDB(B1, 1, 1); PG8_SCHED; PG8_LDA(At, 1, 0); PG8_STAGE(PG8_SA(0, 1), a2 + hstepA, voffA);
            PG8_WAIT_V(8); PG8_WAIT_L(0); PG8_BAR; PG8_MMA(0, 0, At, B0); PG8_MMA(0, 1, At, B1); PG8_BAR; PG8_SCHED;
            PG8_LDA(At, 1, 1); PG8_STAGE(PG8_SB(1, 0), b3, voffB); PG8_STAGE(PG8_SB(1, 1), b3 + hstepB, voffB); PG8_STAGE(PG8_SA(1, 0), a3, voffA);
            PG8_WAIT_V(8); PG8_WAIT_L(0); PG8_BAR; PG8_MMA(1, 0, At, B0); PG8_MMA(1, 1, At, B1); PG8_BAR; PG8_SCHED;
            } else {
            PG8_LDB(B0, 0, 0); PG8_SCHED; PG8_LDA(At, 0, 0); PG8_STAGE(PG8_SA(1, 1), a1 + hstepA, voffA);
            PG8_WAIT_L(8); PG8_BAR; PG8_WAIT_L(0); PG8_MMA(0, 0, At, B0); PG8_BAR; PG8_SCHED;
            PG8_LDB(B1, 0, 1); PG8_STAGE(PG8_SB(0, 0), b2, voffB);
            PG8_BAR; PG8_WAIT_L(0); PG8_MMA(0, 1, At, B1); PG8_BAR;
            PG8_LDA(At, 0, 1); PG8_STAGE(PG8_SA(0, 0), a2, voffA);
            PG8_BAR; PG8_WAIT_L(0); PG8_MMA(1, 0, At, B0); PG8_BAR; PG8_SCHED;
            PG8_STAGE(PG8_SB(0, 1), b2 + hstepB, voffB);
            PG8_WAIT_V(6); PG8_BAR; PG8_MMA(1, 1, At, B1); PG8_BAR;
            PG8_LDB(B0, 1, 0); PG8_SCHED; PG8_LDA(At, 1, 0); PG8_STAGE(PG8_SA(0, 1), a2 + hstepA, voffA);
            PG8_WAIT_L(8); PG8_BAR; PG8_WAIT_L(0); PG8_MMA(0, 0, At, B0); PG8_BAR; PG8_SCHED;
            PG8_LDB(B1, 1, 1); PG8_STAGE(PG8_SB(1, 0), b3, voffB);
            PG8_BAR; PG8_WAIT_L(0); PG8_MMA(0, 1, At, B1); PG8_BAR;
            PG8_LDA(At, 1, 1); PG8_STAGE(PG8_SA(1, 0), a3, voffA);
            PG8_BAR; PG8_WAIT_L(0); PG8_MMA(1, 0, At, B0); PG8_BAR; PG8_SCHED;
            PG8_STAGE(PG8_SB(1, 1), b3 + hstepB, voffB);
            PG8_WAIT_V(6); PG8_BAR; PG8_MMA(1, 1, At, B1); PG8_BAR;
            }
        }
        if constexpr (ALIGN_EPI) { if (wr == 0) PG8_BAR; }
        if constexpr (!Epi::AFTER_DRAIN) { E(acc, cur, wr, wc, fr, fq); S.done(cur); }
        if (!has_next) break;
#pragma unroll
        for (int a = 0; a < 2; ++a)
#pragma unroll
            for (int b = 0; b < 2; ++b)
#pragma unroll
                for (int m = 0; m < 4; ++m)
#pragma unroll
                    for (int n = 0; n < 2; ++n) acc[a][b][m][n] = (f32x4){0.f, 0.f, 0.f, 0.f};
        cur = nxt; cA = nA; cB = nB; ++ui;
        if constexpr (ALIGN_EPI) { if (wr == 1) PG8_BAR; }
    }
    PG8_WAIT_V(0);
    if constexpr (!ALIGN_EPI) { if (wr == 0) PG8_BAR; }
    PG8_BAR;
    if constexpr (Epi::AFTER_DRAIN) { E.fused(acc, cur, wr, wc, fr, fq, lds, wid, lane); S.done(cur); }
#undef PG8_SA
#undef PG8_SB
#undef PG8_STAGE
#undef PG8_LDA
#undef PG8_LDB
#undef PG8_MMA
#undef PG8_WAIT_V
#undef PG8_WAIT_L
#undef PG8_BAR
#undef PG8_SCHED
}
}

#define RLX_AGENT __ATOMIC_RELAXED, __HIP_MEMORY_SCOPE_AGENT
#define LDS_WAIT() asm volatile("s_waitcnt lgkmcnt(0)" ::: "memory")
#define VM_WAIT() asm volatile("s_waitcnt vmcnt(0)" ::: "memory")

#define XB_TMO      128
#define XB_XCNT(j)  (256  + 64 * (j))
#define XB_XSUB(j)  (1280 + 64 * (j))
#define XB_XGEN(j)  (2304 + 64 * (j))
#define XB_TOP      3328
#define XB_TOPGEN   3392
#define XCD_BAR_WORDS 3456
#define XB_SPIN_CAP (1u << 18)

__device__ __forceinline__ unsigned xb_ld(unsigned* p)              { return __hip_atomic_load(p, __ATOMIC_RELAXED, __HIP_MEMORY_SCOPE_AGENT); }
__device__ __forceinline__ unsigned xb_add(unsigned* p, unsigned v) { return __hip_atomic_fetch_add(p, v, __ATOMIC_RELAXED, __HIP_MEMORY_SCOPE_AGENT); }
__device__ __forceinline__ unsigned xb_xcc_id() { return (unsigned)__builtin_amdgcn_s_getreg((3 << 11) | 20) & 0xFu; }
#define XB_SPIN(cond, bar) do { unsigned _sp = 0; while (cond) { __builtin_amdgcn_s_sleep(1); \
    if ((++_sp & 255u) == 0u) { if (xb_ld(&(bar)[XB_TMO])) break; if (_sp > XB_SPIN_CAP) { atomicAdd(&(bar)[XB_TMO], 1u); break; } } } } while (0)

struct XcdBarrier {
    unsigned* bar; unsigned x;
    volatile LAS unsigned* st;
};

__device__ __forceinline__ XcdBarrier xcd_barrier_post(unsigned* bar, volatile LAS unsigned* st) {
    XcdBarrier b; b.bar = bar; b.x = xb_xcc_id(); b.st = st;
    if (threadIdx.x == 0) (void)xb_add(&bar[XB_XCNT(b.x)], 1u);
    return b;
}
__device__ __forceinline__ void xcd_barrier_complete(unsigned* bar, unsigned x, unsigned& nloc, unsigned& nx) {
    const unsigned G = gridDim.x * gridDim.y * gridDim.z;
    unsigned sum, cnt, mine, sp = 0u;
    for (;;) {
        sum = 0u; cnt = 0u; mine = 0u;
#pragma unroll
        for (unsigned j = 0; j < 16; ++j) { const unsigned c = xb_ld(&bar[XB_XCNT(j)]); sum += c; cnt += (c > 0u) ? 1u : 0u; mine = (j == x) ? c : mine; }
        if (sum == G) break;
        __builtin_amdgcn_s_sleep(1);
        if ((++sp & 255u) == 0u) { if (xb_ld(&bar[XB_TMO])) break; if (sp > XB_SPIN_CAP) { atomicAdd(&bar[XB_TMO], 1u); break; } }
    }
    nloc = mine > 0u ? mine : 1u; nx = cnt > 0u ? cnt : 1u;
}

__device__ __forceinline__ void xcd_barrier(const XcdBarrier& b, const bool is_t0  ) {
    asm volatile("s_waitcnt vmcnt(0)" ::: "memory");
    __syncthreads();
    if (is_t0) {
        unsigned* bar = b.bar;
        __builtin_amdgcn_s_waitcnt(0);
        unsigned nloc = b.st[0], nx = b.st[1];
        if (nloc == 0u) { xcd_barrier_complete(bar, b.x, nloc, nx); b.st[0] = nloc; b.st[1] = nx; }
        const unsigned old = xb_add(&bar[XB_XSUB(b.x)], 1u);
        const unsigned gen = old / nloc;
        if (old + 1u == (gen + 1u) * nloc) {
            __builtin_amdgcn_fence(__ATOMIC_RELEASE, "agent");
            asm volatile("s_waitcnt vmcnt(0)" ::: "memory");
            const unsigned og = xb_add(&bar[XB_TOP], 1u);
            const unsigned tg = og / nx;
            if (og + 1u == (tg + 1u) * nx) xb_add(&bar[XB_TOPGEN], 1u);
            else XB_SPIN(xb_ld(&bar[XB_TOPGEN]) == tg, bar);
            __builtin_amdgcn_fence(__ATOMIC_ACQUIRE, "agent");
            xb_add(&bar[XB_XGEN(b.x)], 1u);
            asm volatile("s_waitcnt vmcnt(0)" ::: "memory");
        } else {
            XB_SPIN(xb_ld(&bar[XB_XGEN(b.x)]) == gen, bar);
            __builtin_amdgcn_fence(__ATOMIC_ACQUIRE, "agent");
            asm volatile("s_waitcnt vmcnt(0)" ::: "memory");
        }
    }
    __syncthreads();
}

struct Args { const float* in[20]; float* out; unsigned char* ws; int ph_lo, ph_hi; float inv_ret[128]; float inv_mla[32]; float lg2[16]; };
static_assert(sizeof(Args) == 20 * 8 + 8 + 8 + 8 + (128 + 32 + 16) * 4, "Args has no padding");
struct Frame {
    LAS unsigned char* lds; char* ldsg;
    int tid, lane, wave, vcu, G, gw, NGW;
    int zero;
};
constexpr int AW_OUT = 40, AW_WS = 42, AW_INV_RET = 46, AW_INV_MLA = 46 + 128, AW_LG2 = 46 + 160;
__device__ __forceinline__ unsigned argw(const Frame& F, int w) { return ((const volatile LAS unsigned*)(F.lds + ARGS_OFF + F.zero))[w]; }
__device__ __forceinline__ float argf(const Frame& F, int w) { return __uint_as_float(argw(F, w)); }
__device__ __forceinline__ const float* arg_in(const Frame& F, int k) {
    const unsigned lo = __builtin_amdgcn_readfirstlane(argw(F, 2 * k)), hi = __builtin_amdgcn_readfirstlane(argw(F, 2 * k + 1));
    return (const float*)(const GAS float*)(((unsigned long long)hi << 32) | lo); }
__device__ __forceinline__ unsigned char* arg_ws(const Frame& F) { return (unsigned char*)arg_in(F, AW_WS / 2); }
__device__ __forceinline__ unsigned char* arg_out(const Frame& F) { return (unsigned char*)arg_in(F, AW_OUT / 2); }

__device__ __forceinline__ void sincos_d(double x, double& s, double& c) {
    const double TWO_PI = 6.283185307179586476925286766559, INV_2PI = 0.15915494309189533576888376337251;
    const double k = __builtin_rint(x * INV_2PI); double r = x - k * TWO_PI;
    const double y = r * 0.25, y2 = y * y;
    double sn = y * (1.0 - y2 / 6.0 * (1.0 - y2 / 20.0 * (1.0 - y2 / 42.0 * (1.0 - y2 / 72.0 * (1.0 - y2 / 110.0 * (1.0 - y2 / 156.0 * (1.0 - y2 / 210.0)))))));
    double cs = 1.0 - y2 / 2.0 * (1.0 - y2 / 12.0 * (1.0 - y2 / 30.0 * (1.0 - y2 / 56.0 * (1.0 - y2 / 90.0 * (1.0 - y2 / 132.0 * (1.0 - y2 / 182.0 * (1.0 - y2 / 240.0)))))));
    double s2 = 2.0 * sn * cs, c2 = 1.0 - 2.0 * sn * sn;
    s = 2.0 * s2 * c2; c = 1.0 - 2.0 * s2 * s2;
}
__device__ __forceinline__ void tables_phase(const Frame& F) {
    unsigned char* ws = arg_ws(F);
    float* cosR = (float*)(ws + TAB_COSR); float* sinR = (float*)(ws + TAB_SINR); float* cosM = (float*)(ws + TAB_COSM); float* sinM = (float*)(ws + TAB_SINM);
    const int gt = F.vcu * 512 + F.tid, NT = F.G * 512;
    for (int i = gt; i < LMAX * 160; i += NT) {
        const int t = i / 160, j = i % 160; double s, c;
        if (j < 128) { const float ang = (float)t * argf(F, AW_INV_RET + j); sincos_d((double)ang, s, c); cosR[t * 128 + j] = (float)c; sinR[t * 128 + j] = (float)s; }
        else { const int jm = j - 128; const float ang = (float)t * argf(F, AW_INV_MLA + jm); sincos_d((double)ang, s, c); cosM[t * 32 + jm] = (float)c; sinM[t * 32 + jm] = (float)s; }
    }
}

enum { MAP_ID = 0, MAP_KVB = 1, MAP_QB = 2, MAP_KVA = 3, MAP_ZERO = 4 };
__device__ __forceinline__ int map_col(int mode, int n) {
    if (mode == MAP_KVB) { const int hv = n >> 11, hh = (n & 2047) >> 7, i = n & 127; return hh * 256 + hv * 128 + i; }
    if (mode == MAP_QB)  { const int hh = n / 192, w = n % 192; if (w < 128) return n; const int p = w - 128, j = p >> 1; return hh * 192 + 128 + ((p & 1) ? 32 + j : j); }
    if (mode == MAP_KVA) { if (n < 512) return n; const int p = n - 512, j = p >> 1; return 512 + ((p & 1) ? 32 + j : j); }
    return n;
}
__device__ __forceinline__ void cvt_job(const Frame& F, const float* W, int K, int Nsrc, bf16_t* dst, int nrows, int mode, float scale, const float* gain = nullptr) {
    LAS float* scr = (LAS float*)(F.lds + F.wave * 16384);
    const int nblk = nrows / 32, nitems = (K / 64) * nblk, lane = F.lane;
    for (int it = F.gw; it < nitems; it += F.NGW) {
        const int kb = it / nblk, nb = it % nblk, k0 = 64 * kb, n0 = 32 * nb;
        const int nsrc = map_col(mode, n0 + (lane & 31));
#pragma unroll 8
        for (int i = 0; i < 32; ++i) { const int kk = 2 * i + (lane >> 5); scr[kk * 33 + (lane & 31)] = (mode == MAP_ZERO) ? 0.f : W[(size_t)(k0 + kk) * Nsrc + nsrc] * (gain ? scale * gain[k0 + kk] : scale); }
        LDS_WAIT(); asm volatile("" ::: "memory");
        const int c = lane & 7;
#pragma unroll
        for (int j = 0; j < 4; ++j) { const int n = (lane >> 3) + 8 * j; const LAS float* s = scr + (8 * c) * 33 + n;
            u32x4 o; o.x = cvt_pk_bf16(s[0 * 33], s[1 * 33]); o.y = cvt_pk_bf16(s[2 * 33], s[3 * 33]); o.z = cvt_pk_bf16(s[4 * 33], s[5 * 33]); o.w = cvt_pk_bf16(s[6 * 33], s[7 * 33]);
            *(GAS u32x4*)(dst + (size_t)(n0 + n) * K + k0 + 8 * c) = o; }
        LDS_WAIT(); asm volatile("" ::: "memory");
    }
}
__device__ __forceinline__ void convert_phase(const Frame& F, int L, int part) {
    unsigned char* wr = arg_ws(F) + WS_W; const int j = L >> 1;
    const float* g1 = arg_in(F, 3) + (size_t)L * D;
    if (part != 2) {
    if ((L & 1) == 0) {
        bf16_t* qkv = (bf16_t*)(wr + W_RQKV);
        cvt_job(F, arg_in(F, 7) + (size_t)j * D * 2048, D, 2048, qkv, 2048, MAP_ID, 1.f, g1);
        cvt_job(F, arg_in(F, 8) + (size_t)j * D * 2048, D, 2048, qkv + (size_t)2048 * D, 2048, MAP_ID, 0.0625f, g1);
        cvt_job(F, arg_in(F, 9) + (size_t)j * D * 4096, D, 4096, qkv + (size_t)4096 * D, 4096, MAP_ID, 1.f, g1);
        cvt_job(F, arg_in(F, 10) + (size_t)j * D * 4096, D, 4096, (bf16_t*)(wr + W_RG), 4096, MAP_ID, 1.f, g1);
        cvt_job(F, arg_in(F, 11) + (size_t)j * 4096 * D, 4096, D, (bf16_t*)(wr + W_RO), D, MAP_ID, 1.f);
    } else {
        bf16_t* wa = (bf16_t*)(wr + W_MA);
        cvt_job(F, arg_in(F, 12) + (size_t)j * D * 512, D, 512, wa, 512, MAP_ID, 1.f, g1);
        cvt_job(F, arg_in(F, 15) + (size_t)j * D * 576, D, 576, wa + (size_t)512 * D, 576, MAP_KVA, 1.f, g1);
        cvt_job(F, arg_in(F, 12), D, 512, wa + (size_t)1088 * D, MA_N - 1088, MAP_ZERO, 0.f);
        cvt_job(F, arg_in(F, 14) + (size_t)j * 512 * 3072, 512, 3072, (bf16_t*)(wr + W_MQB), 3072, MAP_QB, 0.10411584120765913f);
        cvt_job(F, arg_in(F, 17) + (size_t)j * 512 * 4096, 512, 4096, (bf16_t*)(wr + W_MKVB), 4096, MAP_KVB, 1.f);
        cvt_job(F, arg_in(F, 18) + (size_t)j * D * D, D, D, (bf16_t*)(wr + W_MO), D, MAP_ID, 1.f);
    }
    cvt_job(F, arg_in(F, 5) + (size_t)L * D * FF, D, FF, (bf16_t*)(wr + W_1), FF, MAP_ID, 1.f);
    }
    if (part != 1) cvt_job(F, arg_in(F, 6) + (size_t)L * FF * D, FF, D, (bf16_t*)(wr + W_2), D, MAP_ID, 1.f);
}

__device__ __forceinline__ void embed_phase(const Frame& F) {
    unsigned char* ws = arg_ws(F); bf16_t* H = (bf16_t*)(ws + WS_H); float* RS = (float*)(ws + WS_RSTD);
    const float* xm = arg_in(F, 2); const float* xp = arg_in(F, 0); const float* xs = arg_in(F, 1);
    for (int r = F.gw; r < MT; r += F.NGW) {
        const int seq = r < ROWS0 ? r / LP_P : NP + (r - ROWS0) / LP_S; const int t = row_tpos(r);
        GAS u32x2* hp = (GAS u32x2*)(H + (size_t)r * D) + F.lane;
        if (t < 0) {
#pragma unroll
            for (int j = 0; j < 8; ++j) hp[64 * j] = (u32x2){0u, 0u};
            if (F.lane == 0) RS[r] = 0.f;
            continue; }
        const float* src = t < NMETA ? xm + (size_t)t * D : (seq < NP ? xp + ((size_t)seq * SP + (t - NMETA)) * D : xs + ((size_t)(seq - NP) * SS + (t - NMETA)) * D);
        float ss = 0.f;
#pragma unroll
        for (int j = 0; j < 8; ++j) { const f32x4 v = __builtin_nontemporal_load((const GAS f32x4*)src + F.lane + 64 * j);
            const unsigned w0 = cvt_pk_bf16(v[0], v[1]), w1 = cvt_pk_bf16(v[2], v[3]); hp[64 * j] = (u32x2){w0, w1};
            const float a0 = bf_lo(w0), a1 = bf_hi(w0), a2 = bf_lo(w1), a3 = bf_hi(w1); ss += (a0 * a0 + a1 * a1) + (a2 * a2 + a3 * a3); }
        const float rstd = 1.0f / sqrtf(wave_sum(ss) * (1.f / D) + NORM_EPS);
        if (F.lane == 0) RS[r] = rstd;
    }
}
__device__ __forceinline__ void rowstat_phase(const Frame& F) {
    unsigned char* ws = arg_ws(F); const bf16_t* H = (const bf16_t*)(ws + WS_H); float* RS = (float*)(ws + WS_RSTD);
    for (int r0 = F.gw; r0 < MT; r0 += 4 * F.NGW) {
        u32x4 w[4][4];
#pragma unroll
        for (int k = 0; k < 4; ++k) { const int r = r0 + k * F.NGW; if (r < MT) { const GAS u32x4* hp = (const GAS u32x4*)(H + (size_t)r * D) + F.lane;
#pragma unroll
            for (int j = 0; j < 4; ++j) w[k][j] = hp[64 * j]; } }
#pragma unroll
        for (int k = 0; k < 4; ++k) { const int r = r0 + k * F.NGW; if (r < MT) { float ss = 0.f;
#pragma unroll
            for (int j = 0; j < 4; ++j)
#pragma unroll
                for (int e = 0; e < 4; ++e) { const float x = bf_lo(w[k][j][e]), y = bf_hi(w[k][j][e]); ss += x * x + y * y; }
            const float rstd = 1.0f / sqrtf(wave_sum(ss) * (1.f / D) + NORM_EPS);
            if (F.lane == 0) RS[r] = rstd; } }
    }
}
__device__ __forceinline__ void norm_phase(const Frame& F, const float* g) {
    unsigned char* ws = arg_ws(F); const bf16_t* H = (const bf16_t*)(ws + WS_H); bf16_t* A = (bf16_t*)(ws + WS_A);
    for (int r0 = F.gw; r0 < MT; r0 += 2 * F.NGW) {
        u32x4 w[2][4];
#pragma unroll
        for (int k = 0; k < 2; ++k) { const int r = r0 + k * F.NGW; if (r < MT) { const GAS u32x4* hp = (const GAS u32x4*)(H + (size_t)r * D) + F.lane;
#pragma unroll
            for (int j = 0; j < 4; ++j) w[k][j] = hp[64 * j]; } }
#pragma unroll
        for (int k = 0; k < 2; ++k) { const int r = r0 + k * F.NGW; if (r < MT) { GAS u32x4* ap = (GAS u32x4*)(A + (size_t)r * D) + F.lane; float ss = 0.f;
#pragma unroll
            for (int j = 0; j < 4; ++j)
#pragma unroll
                for (int e = 0; e < 4; ++e) { const float x = bf_lo(w[k][j][e]), y = bf_hi(w[k][j][e]); ss += x * x + y * y; }
            const float rstd = 1.0f / sqrtf(wave_sum(ss) * (1.f / D) + NORM_EPS);
#pragma unroll
            for (int j = 0; j < 4; ++j) { const f32x4 g0 = *((const GAS f32x4*)g + 2 * (F.lane + 64 * j)), g1 = *((const GAS f32x4*)g + 2 * (F.lane + 64 * j) + 1); u32x4 o;
                o.x = cvt_pk_bf16(bf_lo(w[k][j].x) * rstd * g0[0], bf_hi(w[k][j].x) * rstd * g0[1]); o.y = cvt_pk_bf16(bf_lo(w[k][j].y) * rstd * g0[2], bf_hi(w[k][j].y) * rstd * g0[3]);
                o.z = cvt_pk_bf16(bf_lo(w[k][j].z) * rstd * g1[0], bf_hi(w[k][j].z) * rstd * g1[1]); o.w = cvt_pk_bf16(bf_lo(w[k][j].w) * rstd * g1[2], bf_hi(w[k][j].w) * rstd * g1[3]);
                ap[64 * j] = o; } } }
    }
}
__device__ __forceinline__ void final_phase(const Frame& F) {
    const bf16_t* H = (const bf16_t*)(arg_ws(F) + WS_H); const float* g = arg_in(F, 19); float* outp = (float*)arg_out(F);
    constexpr int NREAL = NP * SP + NS * SS;
    for (int i = F.gw; i < NREAL; i += F.NGW) {
        int r; if (i < NP * SP) r = (i / SP) * LP_P + PADF + NMETA + (i % SP); else { const int k = i - NP * SP; r = ROWS0 + (k / SS) * LP_S + PADF + NMETA + (k % SS); }
        const GAS u32x4* hp = (const GAS u32x4*)(H + (size_t)r * D) + F.lane; GAS f32x4* op = (GAS f32x4*)(outp + (size_t)i * D);
        u32x4 w[4]; float ss = 0.f;
#pragma unroll
        for (int j = 0; j < 4; ++j) { w[j] = __builtin_nontemporal_load(hp + 64 * j);
#pragma unroll
            for (int e = 0; e < 4; ++e) { const float x = bf_lo(w[j][e]), y = bf_hi(w[j][e]); ss += x * x + y * y; } }
        const float rstd = 1.0f / sqrtf(wave_sum(ss) * (1.f / D) + NORM_EPS);
#pragma unroll
        for (int j = 0; j < 4; ++j) { const int c2 = 2 * (F.lane + 64 * j); const f32x4 g0 = *((const GAS f32x4*)g + c2), g1 = *((const GAS f32x4*)g + c2 + 1);
            __builtin_nontemporal_store((f32x4){bf_lo(w[j].x) * rstd * g0[0], bf_hi(w[j].x) * rstd * g0[1], bf_lo(w[j].y) * rstd * g0[2], bf_hi(w[j].y) * rstd * g0[3]}, op + c2);
            __builtin_nontemporal_store((f32x4){bf_lo(w[j].z) * rstd * g1[0], bf_hi(w[j].z) * rstd * g1[1], bf_lo(w[j].w) * rstd * g1[2], bf_hi(w[j].w) * rstd * g1[3]}, op + c2 + 1); }
    }
}

__device__ __forceinline__ void ret_combine_phase(const Frame& F, const bf16_t* OF, const bf16_t* OB, const bf16_t* Gt, bf16_t* U, int rows) {
    const int nitems = rows * RH;
    for (int it0 = F.gw; it0 < nitems; it0 += 4 * F.NGW) {
        u32x4 a[4], b[4], g[4];
#pragma unroll
        for (int k = 0; k < 4; ++k) { const int it = it0 + k * F.NGW; if (it < nitems) { const size_t off = (size_t)it * 512 + F.lane * 8;
            a[k] = __builtin_nontemporal_load((const GAS u32x4*)(OF + off)); b[k] = __builtin_nontemporal_load((const GAS u32x4*)(OB + off)); g[k] = __builtin_nontemporal_load((const GAS u32x4*)(Gt + off)); } }
#pragma unroll
        for (int k = 0; k < 4; ++k) { const int it = it0 + k * F.NGW; if (it < nitems) { const size_t off = (size_t)it * 512 + F.lane * 8;
            float o[8]; float s = 0.f;
#pragma unroll
            for (int e = 0; e < 4; ++e) { o[2 * e] = bf_lo(a[k][e]) + bf_lo(b[k][e]); o[2 * e + 1] = bf_hi(a[k][e]) + bf_hi(b[k][e]); s += o[2 * e] + o[2 * e + 1]; }
            const float mu = wave_sum(s) * (1.f / 512.f); float q = 0.f;
#pragma unroll
            for (int e = 0; e < 8; ++e) { o[e] -= mu; q += o[e] * o[e]; }
            const float rstd = 1.0f / sqrtf(wave_sum(q) * (1.f / 512.f) + NORM_EPS);
            u32x4 w;
#pragma unroll
            for (int e = 0; e < 4; ++e) { const float g0 = bf_lo(g[k][e]), g1 = bf_hi(g[k][e]);
                const float y0 = o[2 * e] * rstd, y1 = o[2 * e + 1] * rstd;
                const float s0 = g0 / (1.f + __expf(-g0)), s1 = g1 / (1.f + __expf(-g1));
                w[e] = cvt_pk_bf16(s0 * y0, s1 * y1); }
            *(GAS u32x4*)(U + off) = w; } }
    }
}

__device__ __forceinline__ void mla_rowpass_phase(const Frame& F, int j, const bf16_t* CQKV, bf16_t* CN, bf16_t* KR, int rows, int grow0) {
    const float* gq = arg_in(F, 13) + (size_t)j * 512; const float* gkv = arg_in(F, 16) + (size_t)j * 512; unsigned char* ws = arg_ws(F);
    const float* cosM = (const float*)(ws + TAB_COSM); const float* sinM = (const float*)(ws + TAB_SINM);
    for (int r = F.gw; r < rows; r += F.NGW) {
        const bf16_t* src = CQKV + (size_t)r * MA_N;
        const u32x4 wq = *(const GAS u32x4*)(src + F.lane * 8), wk = *(const GAS u32x4*)(src + 512 + F.lane * 8);
        float q[8], k[8]; float sq = 0.f, sk = 0.f;
#pragma unroll
        for (int e = 0; e < 4; ++e) { q[2 * e] = bf_lo(wq[e]); q[2 * e + 1] = bf_hi(wq[e]); k[2 * e] = bf_lo(wk[e]); k[2 * e + 1] = bf_hi(wk[e]);
            sq += q[2 * e] * q[2 * e] + q[2 * e + 1] * q[2 * e + 1]; sk += k[2 * e] * k[2 * e] + k[2 * e + 1] * k[2 * e + 1]; }
        const float rq = 1.0f / sqrtf(wave_sum(sq) * (1.f / 512.f) + NORM_EPS), rk = 1.0f / sqrtf(wave_sum(sk) * (1.f / 512.f) + NORM_EPS);
        const f32x4 gq0 = *((const GAS f32x4*)gq + 2 * F.lane), gq1 = *((const GAS f32x4*)gq + 2 * F.lane + 1), gk0 = *((const GAS f32x4*)gkv + 2 * F.lane), gk1 = *((const GAS f32x4*)gkv + 2 * F.lane + 1);
        u32x4 oq, ok;
        oq.x = cvt_pk_bf16(q[0] * rq * gq0[0], q[1] * rq * gq0[1]); oq.y = cvt_pk_bf16(q[2] * rq * gq0[2], q[3] * rq * gq0[3]); oq.z = cvt_pk_bf16(q[4] * rq * gq1[0], q[5] * rq * gq1[1]); oq.w = cvt_pk_bf16(q[6] * rq * gq1[2], q[7] * rq * gq1[3]);
        ok.x = cvt_pk_bf16(k[0] * rk * gk0[0], k[1] * rk * gk0[1]); ok.y = cvt_pk_bf16(k[2] * rk * gk0[2], k[3] * rk * gk0[3]); ok.z = cvt_pk_bf16(k[4] * rk * gk1[0], k[5] * rk * gk1[1]); ok.w = cvt_pk_bf16(k[6] * rk * gk1[2], k[7] * rk * gk1[3]);
        *(GAS u32x4*)(CN + (size_t)r * 1024 + F.lane * 8) = oq; *(GAS u32x4*)(CN + (size_t)r * 1024 + 512 + F.lane * 8) = ok;
        if (F.lane < 32) {
            const unsigned w = *(const GAS unsigned*)(src + 1024 + 2 * F.lane); int t = row_tpos(grow0 + r); t = t < 0 ? 0 : t;
            const float x1 = bf_lo(w), x2 = bf_hi(w), c = cosM[(size_t)t * 32 + F.lane], s = sinM[(size_t)t * 32 + F.lane];
            *(GAS unsigned*)(KR + (size_t)r * 64 + 2 * F.lane) = cvt_pk_bf16(x1 * c - x2 * s, x1 * s + x2 * c);
        }
    }
}

namespace rscan {
constexpr int RS = 272;
constexpr int L_Q = 0, L_K = 128 * RS, L_V = 2 * 128 * RS, L_P = 3 * 128 * RS, L_END = 4 * 128 * RS;
static_assert(L_END <= ARGS_OFF, "scan LDS");
typedef short v4i16_t __attribute__((ext_vector_type(4)));
__device__ __forceinline__ s16x4 tr_read(LAS unsigned char* p) { return __builtin_bit_cast(s16x4, __builtin_amdgcn_ds_read_tr16_b64_v4i16((LAS v4i16_t*)p)); }
__device__ __forceinline__ bf16x8 pack8(s16x4 lo, s16x4 hi) { return (bf16x8){lo[0], lo[1], lo[2], lo[3], hi[0], hi[1], hi[2], hi[3]}; }

constexpr int PS = 528;
__device__ __forceinline__ void pmat_phase(const Frame& F, const bf16_t* Q, const bf16_t* K, bf16_t* PB, int half) {
    const int nseq = half ? NS : NP, nchunk = half ? LP_S / 128 : LP_P / 128;
    const int nunits = nseq * nchunk * RH;
    const int tid = F.tid, lane = tid & 63, wv = tid >> 6, l15 = lane & 15, quad = lane >> 4;
    LAS unsigned char* const lg = F.lds;
    LAS unsigned char* const bQown = lg + (16 * wv + l15) * PS + 16 * quad;
    LAS unsigned char* const bK    = lg + 128 * PS + l15 * PS + 16 * quad;
    const int srow = tid >> 5, scc = tid & 31;
    for (int u = F.vcu; u < nunits; u += F.G) {
        const int head = u & 7, sc = u >> 3;
        const float lgf = __uint_as_float(__builtin_amdgcn_readfirstlane(argw(F, AW_LG2 + head))), lgb = __uint_as_float(__builtin_amdgcn_readfirstlane(argw(F, AW_LG2 + 8 + head)));
        const size_t u0 = (size_t)sc * 128 * 2048 + head * 256; const unsigned lq = (unsigned)(srow * 2048 + scc * 8);
#pragma unroll
        for (int ii = 0; ii < 8; ++ii) { const u32x4 qv = *(const GAS u32x4*)(Q + u0 + (size_t)ii * 16 * 2048 + lq), kv = *(const GAS u32x4*)(K + u0 + (size_t)ii * 16 * 2048 + lq);
            *(LAS u32x4*)(lg + (srow + 16 * ii) * PS + scc * 16) = qv; *(LAS u32x4*)(lg + 128 * PS + (srow + 16 * ii) * PS + scc * 16) = kv; }
        __syncthreads();
        bf16x8 Qf[8];
#pragma unroll
        for (int ks = 0; ks < 8; ++ks) Qf[ks] = *(const LAS bf16x8*)(bQown + 64 * ks);
        bf16_t* pout = PB + (size_t)u * 16384; const unsigned lpo = (unsigned)((16 * wv + l15) * 128 + 4 * quad); const int i_abs = 16 * wv + l15;
#pragma unroll
        for (int jt = 0; jt < 8; ++jt) { f32x4 st = {0.f, 0.f, 0.f, 0.f};
#pragma unroll
            for (int ks = 0; ks < 8; ++ks) { const bf16x8 Kf = *(const LAS bf16x8*)(bK + 16 * jt * PS + 64 * ks); st = __builtin_amdgcn_mfma_f32_16x16x32_bf16(Kf, Qf[ks], st, 0, 0, 0); }
#pragma unroll
            for (int r = 0; r < 4; ++r) { const int jj = 16 * jt + 4 * quad + r;
                st[r] *= __builtin_amdgcn_exp2f(jj <= i_abs ? lgf * (float)(-jj - 1) : lgb * (float)(jj - 128)); }
            *(GAS u32x2*)(pout + 16 * jt + lpo) = (u32x2){cvt_pk_bf16(st[0], st[1]), cvt_pk_bf16(st[2], st[3])}; }
        __syncthreads();
    }
}

__device__ __forceinline__ void glds16s(const void* gsrc, unsigned lds_dst) { unsigned keep;
    asm volatile("s_mov_b32 %0, m0\n\ts_mov_b32 m0, %2\n\ts_nop 0\n\tglobal_load_lds_dwordx4 %1, off\n\ts_mov_b32 m0, %0" : "=&s"(keep) : "v"(gsrc), "s"(lds_dst) : "memory"); }
__device__ __forceinline__ void glds16u(const void* sbase, unsigned voff, unsigned lds_dst) { unsigned keep;
    asm volatile("s_mov_b32 %0, m0\n\ts_mov_b32 m0, %3\n\ts_nop 0\n\tglobal_load_lds_dwordx4 %1, %2\n\ts_mov_b32 m0, %0" : "=&s"(keep) : "v"(voff), "s"(sbase), "s"(lds_dst) : "memory"); }
#define SCAN_BAR() asm volatile("s_waitcnt lgkmcnt(0)\n\ts_barrier" ::: "memory")
__device__ __forceinline__ int qk_swz(int r) { return ((r >> 1) & 1) | ((((r >> 1) ^ (r >> 2)) & 1) << 1) | (((r >> 3) & 1) << 2); }
constexpr int QS = 128, S_QK = 128 * QS  , LQ0 = 0, LQ1 = S_QK, LK0 = 2 * S_QK, LK1 = 3 * S_QK, LV2 = 4 * S_QK  , LP2 = LV2 + 32768, L_END2 = LP2 + 32768;
static_assert(L_END2 <= ARGS_OFF, "scan LDS");
constexpr int pv_pair(int dir, int n) { int c = 0; for (int it = 0; it < 8; ++it) for (int ks = 0; ks < 4; ++ks) { const int dks = ks - (it >> 1); if (dir ? dks >= 0 : dks <= 0) { if (c == n) return it * 4 + ks; ++c; } } return -1; }
template <int M, int N, class Fn> __device__ __forceinline__ void mattn_sfor(Fn&& f) { if constexpr (M < N) { f(std::integral_constant<int, M>{}); mattn_sfor<M + 1, N>(f); } }
__device__ __forceinline__ void scan_phase(const Frame& F, const bf16_t* Q, const bf16_t* K, const bf16_t* V, const bf16_t* PB, bf16_t* OF, bf16_t* OB, int half) {
    const int nseq = half ? NS : NP, nchunk = half ? LP_S / 128 : LP_P / 128, Lp = nchunk * 128;
    const int nunits = nseq * RH * 2 * 4;
    const int tid = F.tid, lane = tid & 63, wv = tid >> 6  , l15 = lane & 15, quad = lane >> 4;
    LAS unsigned char* const lg = F.lds;
    LAS unsigned char* bQs[2][2];
#pragma unroll
    for (int ks = 0; ks < 2; ++ks)
#pragma unroll
        for (int sec = 0; sec < 2; ++sec) bQs[ks][sec] = lg + l15 * QS + (((4 * ks + 2 * sec + (quad >> 1)) ^ qk_swz(l15)) << 4) + 8 * (quad & 1);
    LAS unsigned char* bKlo[4]; LAS unsigned char* bKhi[4];
#pragma unroll
    for (int mt = 0; mt < 4; ++mt) { const int kr = 8 * quad + (l15 >> 2), kc = 2 * mt + ((l15 & 3) >> 1);
        bKlo[mt] = lg + kr * QS + ((kc ^ qk_swz(kr)) << 4) + 8 * (l15 & 1); bKhi[mt] = lg + (kr + 4) * QS + ((kc ^ qk_swz(kr + 4)) << 4) + 8 * (l15 & 1); }
    const int vx = 8 * (quad & 1) + (l15 >> 2), vch = 2 * wv + ((l15 & 3) >> 1);
    LAS unsigned char* const bVlo  = lg + LV2 + (8 * quad + (l15 >> 2)) * 256 + ((vch ^ vx) << 4) + 8 * (l15 & 1);
    LAS unsigned char* const bVhi  = lg + LV2 + (8 * quad + (l15 >> 2) + 4) * 256 + ((vch ^ vx ^ 4) << 4) + 8 * (l15 & 1);
    LAS unsigned char* bPk[4];
#pragma unroll
    for (int ks = 0; ks < 4; ++ks) bPk[ks] = lg + LP2 + l15 * 256 + ((((4 * ks + quad) ^ l15) & 15) << 4);
    const int drow0 = 16 * wv + (lane >> 4); unsigned dc8[4];
#pragma unroll
    for (int n = 0; n < 4; ++n) dc8[n] = (unsigned)((((lane & 15) ^ ((drow0 + 4 * n) & 15))) * 8);
    const unsigned ldsV = (unsigned)(uintptr_t)F.ldsg + LV2 + F.wave * 4096, ldsP = (unsigned)(uintptr_t)F.ldsg + LP2 + F.wave * 4096;
    const int srow = tid >> 3, scc = tid & 7;
    LAS unsigned char* const bSt = lg + srow * QS + ((scc ^ qk_swz(srow)) << 4);
    const unsigned lqk = (unsigned)(srow * 2048 + scc * 8);
    for (int u = blockIdx.x; u < nunits; u += F.G) {
        const int x = u & 7, loc = u >> 3, vq = loc & 3, grp = (loc >> 2) * 8 + x;
        const int dirr = grp & 1, head = (grp >> 1) & 7, seq = grp >> 4;
        const float lg2 = __uint_as_float(__builtin_amdgcn_readfirstlane(argw(F, AW_LG2 + dirr * 8 + head)));
        const float c1 = __builtin_amdgcn_exp2f(128.f * lg2);
        const size_t rb = (size_t)seq * Lp;
        bf16_t* O = dirr ? OB : OF;
        auto unit_body = [&](auto dir_c) { constexpr int dir = decltype(dir_c)::value;
        int drow0_l = drow0; unsigned dc8_l[4] = {dc8[0], dc8[1], dc8[2], dc8[3]}; asm volatile("" : "+v"(drow0_l), "+v"(dc8_l[0]), "+v"(dc8_l[1]), "+v"(dc8_l[2]), "+v"(dc8_l[3]));
        const float gm1 = __uint_as_float(__builtin_amdgcn_readfirstlane(__float_as_uint(__builtin_amdgcn_exp2f(dir ? lg2 : -lg2)))), gm32 = __uint_as_float(__builtin_amdgcn_readfirstlane(__float_as_uint(__builtin_amdgcn_exp2f((dir ? 32.f : -32.f) * lg2)))),
                    gm16 = __uint_as_float(__builtin_amdgcn_readfirstlane(__float_as_uint(__builtin_amdgcn_exp2f((dir ? -16.f : 16.f) * lg2))));
        unsigned lqk_l = lqk; asm volatile("" : "+v"(lqk_l));
        f32x4 Rt[16];
#pragma unroll
        for (int i = 0; i < 16; ++i) Rt[i] = (f32x4){0.f, 0.f, 0.f, 0.f};
        u32x4 rq[2], rk[2];
#define SCAN_LOAD_QK(cc, pq) do { const size_t u0_ = (rb + (size_t)(cc) * 128) * 2048 + head * 256 + (pq) * 64;     \
            _Pragma("unroll") for (int ii = 0; ii < 2; ++ii) { rq[ii] = *(const GAS u32x4*)(Q + u0_ + (size_t)ii * 64 * 2048 + lqk_l); rk[ii] = *(const GAS u32x4*)(K + u0_ + (size_t)ii * 64 * 2048 + lqk_l); } } while (0)
#define SCAN_WRITE_QK(par) do { _Pragma("unroll") for (int ii = 0; ii < 2; ++ii) { *(LAS u32x4*)(bSt + ((par) ? LQ1 : LQ0) + ii * 64 * QS) = rq[ii]; *(LAS u32x4*)(bSt + ((par) ? LK1 : LK0) + ii * 64 * QS) = rk[ii]; } } while (0)
#define SCAN_DMA_VP(cc) do { const bf16_t* vs_ = V + (rb + (size_t)(cc) * 128) * 4096 + head * 512 + vq * 128; const bf16_t* ps_ = PB + ((size_t)(seq * nchunk + (cc)) * RH + head) * 16384; \
            _Pragma("unroll") for (int n_ = 0; n_ < 4; ++n_) { glds16u(vs_, ((unsigned)(drow0_l + 4 * n_) * 4096u + dc8_l[n_]) * 2u, ldsV + n_ * 1024); glds16u(ps_, ((unsigned)(drow0_l + 4 * n_) * 128u + dc8_l[n_]) * 2u, ldsP + n_ * 1024); } } while (0)
        unsigned pmk[2][4];
#pragma unroll
        for (int par = 0; par < 2; ++par) { int nk = 16 * par + l15 - 8 * quad + 1; nk = nk < 0 ? 0 : (nk > 8 ? 8 : nk);
#pragma unroll
            for (int d_ = 0; d_ < 4; ++d_) { const unsigned mf = ((2 * d_ < nk) ? 0xffffu : 0u) | ((2 * d_ + 1 < nk) ? 0xffff0000u : 0u); pmk[par][d_] = dir ? ~mf : mf; } }
        { const int c0 = dir ? nchunk - 1 : 0; SCAN_DMA_VP(c0); SCAN_LOAD_QK(c0, 0); SCAN_WRITE_QK(0); SCAN_LOAD_QK(c0, 1); }
        SCAN_BAR();
        for (int s = 0; s < nchunk; ++s) {
            const int c = dir ? nchunk - 1 - s : s, cn = dir ? nchunk - 2 - s : s + 1; const size_t r0 = rb + (size_t)c * 128; const bool more = s + 1 < nchunk;
            f32x4 Ot[8]; bf16x8 Vf[4];
#pragma unroll
            for (int i = 0; i < 8; ++i) Ot[i] = (f32x4){0.f, 0.f, 0.f, 0.f};
            int quad_l = quad, l15_l = l15; asm volatile("" : "+v"(quad_l), "+v"(l15_l));
#pragma unroll
            for (int p = 0; p < 4; ++p) {
                if (p < 3 || more) SCAN_WRITE_QK((p + 1) & 1);
                if (p == 1 && more) SCAN_DMA_VP(cn);
                if (p < 2) SCAN_LOAD_QK(c, p + 2); else if (more) SCAN_LOAD_QK(cn, p - 2);
                if (p == 0) {
#pragma unroll
                    for (int ks = 0; ks < 4; ++ks) { const s16x4 lo = tr_read(bVlo + 32 * ks * 256), hi = tr_read(bVhi + 32 * ks * 256); Vf[ks] = pack8(lo, hi); }
                    __builtin_amdgcn_sched_barrier(0);
                    { u32x4 pwb[2];
                      { constexpr int q0_ = pv_pair(dir, 0); pwb[0] = *(const LAS u32x4*)(bPk[q0_ & 3] + 16 * (q0_ >> 2) * 256); }
                      __builtin_amdgcn_sched_group_barrier(0x100, 1, 0);
                      mattn_sfor<0, 20>([&](auto n_) { constexpr int n = decltype(n_)::value, pr = pv_pair(dir, n), it = pr >> 2, ks = pr & 3, dks = ks - (it >> 1);
                          if constexpr (n + 1 < 20) { constexpr int nx = pv_pair(dir, n + 1); pwb[(n + 1) & 1] = *(const LAS u32x4*)(bPk[nx & 3] + 16 * (nx >> 2) * 256); }
                          u32x4 pw = pwb[n & 1];
                          if constexpr (dks == 0) { pw.x &= pmk[it & 1][0]; pw.y &= pmk[it & 1][1]; pw.z &= pmk[it & 1][2]; pw.w &= pmk[it & 1][3]; }
                          Ot[it] = __builtin_amdgcn_mfma_f32_16x16x32_bf16(Vf[ks], __builtin_bit_cast(bf16x8, pw), Ot[it], 0, 0, 0);
                          __builtin_amdgcn_sched_group_barrier(0x100, 1, 0); __builtin_amdgcn_sched_group_barrier(0x8, 1, 0); }); }
                    __builtin_amdgcn_sched_barrier(0);
                    { float fk = __builtin_amdgcn_exp2f(lg2 * (float)(dir ? 8 * quad_l : 127 - 8 * quad_l));
#pragma unroll
                      for (int ks = 0; ks < 4; ++ks) { u32x4 vw = __builtin_bit_cast(u32x4, Vf[ks]); float f = fk;
#pragma unroll
                        for (int e2 = 0; e2 < 4; ++e2) { const float f0 = f, f1 = f * gm1; f = f1 * gm1;
                            vw[e2] = cvt_pk_bf16(bf_lo(vw[e2]) * f0, bf_hi(vw[e2]) * f1); }
                        Vf[ks] = __builtin_bit_cast(bf16x8, vw); fk *= gm32; } }
                }
                __builtin_amdgcn_sched_barrier(0);
                {
                    bf16x8 Rf[2];
#pragma unroll
                    for (int ks = 0; ks < 2; ++ks) { const f32x4 r0v = Rt[4 * p + 2 * ks], r1v = Rt[4 * p + 2 * ks + 1];
                        const u32x4 wvv = {cvt_pk_bf16(r0v[0], r0v[1]), cvt_pk_bf16(r0v[2], r0v[3]), cvt_pk_bf16(r1v[0], r1v[1]), cvt_pk_bf16(r1v[2], r1v[3])};
                        Rf[ks] = __builtin_bit_cast(bf16x8, wvv); }
                    u32x4 qf[2][2];
#define SCAN_QREAD(b_, it_) do { _Pragma("unroll") for (int ks = 0; ks < 2; ++ks) { const int qo = ((p & 1) ? LQ1 : LQ0) + 16 * (it_) * QS; \
                        const u32x2 lo = *(const volatile LAS u32x2*)(bQs[ks][0] + qo), hi = *(const volatile LAS u32x2*)(bQs[ks][1] + qo);     qf[b_][ks] = (u32x4){lo.x, lo.y, hi.x, hi.y}; } } while (0)
                    SCAN_QREAD(0, 0);
#pragma unroll
                    for (int it = 0; it < 8; ++it) { if (it < 7) SCAN_QREAD((it + 1) & 1, it + 1);
#pragma unroll
                        for (int ks = 0; ks < 2; ++ks) Ot[it] = __builtin_amdgcn_mfma_f32_16x16x32_bf16(Rf[ks], __builtin_bit_cast(bf16x8, qf[it & 1][ks]), Ot[it], 0, 0, 0); }
#undef SCAN_QREAD
                    __builtin_amdgcn_sched_group_barrier(0x100, 4, 0);
                    __builtin_amdgcn_sched_group_barrier(0x100, 4, 0); __builtin_amdgcn_sched_group_barrier(0x8, 2, 0);
                    __builtin_amdgcn_sched_group_barrier(0x100, 4, 0); __builtin_amdgcn_sched_group_barrier(0x8, 2, 0);
                    __builtin_amdgcn_sched_group_barrier(0x100, 4, 0); __builtin_amdgcn_sched_group_barrier(0x8, 2, 0);
                    __builtin_amdgcn_sched_group_barrier(0x100, 4, 0); __builtin_amdgcn_sched_group_barrier(0x8, 2, 0);
                    __builtin_amdgcn_sched_group_barrier(0x100, 4, 0); __builtin_amdgcn_sched_group_barrier(0x8, 2, 0);
                    __builtin_amdgcn_sched_group_barrier(0x100, 4, 0); __builtin_amdgcn_sched_group_barrier(0x8, 2, 0);
                    __builtin_amdgcn_sched_group_barrier(0x100, 4, 0); __builtin_amdgcn_sched_group_barrier(0x8, 2, 0);
                    __builtin_amdgcn_sched_group_barrier(0x8, 2, 0);
                }
                __builtin_amdgcn_sched_barrier(0);
                { s16x4 kl[2][4], kh[2][4];
#define SCAN_KREAD(b_, mt_) do { _Pragma("unroll") for (int ks = 0; ks < 4; ++ks) { const int ko = ((p & 1) ? LK1 : LK0) + 32 * ks * QS; kl[b_][ks] = tr_read(bKlo[mt_] + ko); kh[b_][ks] = tr_read(bKhi[mt_] + ko); } } while (0)
                SCAN_KREAD(0, 0);
#pragma unroll
                for (int mt = 0; mt < 4; ++mt) { if (mt < 3) SCAN_KREAD((mt + 1) & 1, mt + 1);
                    f32x4 acc = Rt[4 * p + mt] * c1;
#pragma unroll
                    for (int ks = 0; ks < 4; ++ks) acc = __builtin_amdgcn_mfma_f32_16x16x32_bf16(pack8(kl[mt & 1][ks], kh[mt & 1][ks]), Vf[ks], acc, 0, 0, 0);
                    Rt[4 * p + mt] = acc; }
#undef SCAN_KREAD
                __builtin_amdgcn_sched_group_barrier(0x100, 8, 0);
                __builtin_amdgcn_sched_group_barrier(0x100, 8, 0); __builtin_amdgcn_sched_group_barrier(0x8, 4, 0);
                __builtin_amdgcn_sched_group_barrier(0x100, 8, 0); __builtin_amdgcn_sched_group_barrier(0x8, 4, 0);
                __builtin_amdgcn_sched_group_barrier(0x100, 8, 0); __builtin_amdgcn_sched_group_barrier(0x8, 4, 0);
                __builtin_amdgcn_sched_group_barrier(0x8, 4, 0);
                }
                if (p == 3) {
                    bf16_t* ob_ = O + r0 * 4096 + head * 512 + vq * 128; const unsigned lo_ = (unsigned)(l15_l * 4096 + 16 * wv + 4 * quad);
                    float fi = __builtin_amdgcn_exp2f(lg2 * (float)(dir ? 128 - l15_l : l15_l + 1));
#pragma unroll
                    for (int it = 0; it < 8; ++it) {
                        *(GAS u32x2*)(ob_ + (size_t)(16 * it) * 4096 + lo_) = (u32x2){cvt_pk_bf16(Ot[it][0] * fi, Ot[it][1] * fi), cvt_pk_bf16(Ot[it][2] * fi, Ot[it][3] * fi)}; fi *= gm16; }
                }
                SCAN_BAR();
            }
        }
        };
        if (dirr) unit_body(std::integral_constant<int, 1>{}); else unit_body(std::integral_constant<int, 0>{});
#undef SCAN_LOAD_QK
#undef SCAN_DMA_VP
#undef SCAN_WRITE_QK
    }
}
}

namespace mattn {
constexpr int NW = 8, QBLK = 32, KVBLK = 64;
constexpr int SHM_V = KVBLK * MV * 2  , SHM_K = KVBLK * MQK * 2  , SHM_QR = 2 * SHM_V + 2 * SHM_K + NW * 64 * 4  , NQL = 0  , SHM_ATTN = SHM_QR + NW * NQL * 1024;
static_assert(SHM_ATTN <= ARGS_OFF, "attention LDS");
constexpr float THR2 = 11.0f;
#define KSWZ(row, colB) ((row) * 384 + ((colB) ^ (((row) & 7) << 4)))
#define SBAR() __builtin_amdgcn_sched_barrier(0)
#define PIN2(A, B) asm volatile("" : "+v"(A), "+v"(B))
__device__ __forceinline__ int crow(int r, int hi) { return (r & 3) + 8 * (r >> 2) + 4 * hi; }
typedef __bf16 bf16x2_n __attribute__((ext_vector_type(2)));
typedef float f32x2_n __attribute__((ext_vector_type(2)));
__device__ __forceinline__ unsigned cvt_pk_n(float lo, float hi) { f32x2_n v = {lo, hi}; return __builtin_bit_cast(unsigned, __builtin_convertvector(v, bf16x2_n)); }
__device__ __forceinline__ bf16x8 pk_swz(unsigned a0, unsigned a1, unsigned b0, unsigned b1) {
    auto r0 = __builtin_amdgcn_permlane32_swap(a0, b0, false, false); auto r1 = __builtin_amdgcn_permlane32_swap(a1, b1, false, false);
    u32x4 w = {r0[0], r1[0], r0[1], r1[1]}; return __builtin_bit_cast(bf16x8, w); }
template <int M, int N, class Fn> __device__ __forceinline__ void sfor(Fn&& f) { if constexpr (M < N) { f(std::integral_constant<int, M>{}); sfor<M + 1, N>(f); } }
struct PsmSt { float c0, c1, mn; };
template <int N> __device__ __forceinline__ void psm_slice(f32x16& p0, f32x16& p1, float& m_reg, float& alpha, PsmSt& st) {
    if constexpr (N == 0) { float c = fmaxf(p0[0], p0[1]);
#pragma unroll
        for (int r = 2; r < 16; r += 2) c = fmaxf(fmaxf(c, p0[r]), p0[r + 1]);
        st.c0 = c; }
    else if constexpr (N == 1) { float c = fmaxf(p1[0], p1[1]);
#pragma unroll
        for (int r = 2; r < 16; r += 2) c = fmaxf(fmaxf(c, p1[r]), p1[r + 1]);
        st.c1 = c; }
    else if constexpr (N == 2) { float pmax = fmaxf(st.c0, st.c1);
        auto rr = __builtin_amdgcn_permlane32_swap(__float_as_uint(pmax), __float_as_uint(pmax), false, false); pmax = fmaxf(__uint_as_float(rr[0]), __uint_as_float(rr[1]));
        const bool keep = __all(pmax - m_reg <= THR2);
        st.mn = keep ? m_reg : fmaxf(m_reg, pmax); }
    else if constexpr (N == 3) { alpha = __builtin_amdgcn_exp2f(m_reg - st.mn); m_reg = st.mn; }
    else if constexpr (N < 8) { constexpr int r = 2 * (N - 4); p0[r] = __builtin_amdgcn_exp2f(p0[r] - st.mn); p0[r + 1] = __builtin_amdgcn_exp2f(p0[r + 1] - st.mn); }
    else { constexpr int r = N; p0[r] = __builtin_amdgcn_exp2f(p0[r] - st.mn); }
}
struct FinSt { float s0, s1; unsigned c[16]; };
template <int M> __device__ __forceinline__ void fin_slice(f32x16& p0, f32x16& p1, float mreg, float alpha, float& l_reg, FinSt& st, bf16x8 (&pa)[4]) {
    if constexpr (M < 16) {
        p1[M] = __builtin_amdgcn_exp2f(p1[M] - mreg);
        if constexpr (M == 0) st.s0 = p0[0]; else st.s0 += p0[M];
        if constexpr ((M & 1) == 0) st.c[M / 2] = cvt_pk_n(p0[M], p0[M + 1]);
    } else if constexpr (M < 20) {
        constexpr int k = M - 16;
        if constexpr (k == 0) st.s1 = p1[0]; else st.s1 += p1[4 * k];
        st.s1 += p1[4 * k + 1]; st.s1 += p1[4 * k + 2]; st.s1 += p1[4 * k + 3];
        st.c[8 + 2 * k] = cvt_pk_n(p1[4 * k], p1[4 * k + 1]); st.c[9 + 2 * k] = cvt_pk_n(p1[4 * k + 2], p1[4 * k + 3]);
        if constexpr (k == 0) pa[0] = pk_swz(st.c[0], st.c[1], st.c[2], st.c[3]);
        if constexpr (k == 1) pa[1] = pk_swz(st.c[4], st.c[5], st.c[6], st.c[7]);
    } else if constexpr (M == 20) pa[2] = pk_swz(st.c[8], st.c[9], st.c[10], st.c[11]);
    else if constexpr (M == 21) pa[3] = pk_swz(st.c[12], st.c[13], st.c[14], st.c[15]);
    else if constexpr (M == 22) { float ps = st.s0 + st.s1;
        auto rr = __builtin_amdgcn_permlane32_swap(__float_as_uint(ps), __float_as_uint(ps), false, false); ps = __uint_as_float(rr[0]) + __uint_as_float(rr[1]);
        l_reg = l_reg * alpha + ps; }
}
__device__ __forceinline__ int v_st(int k, int c) { const int kk = (k & ~0xC) | ((k & 4) << 1) | ((k & 8) >> 1); return ((kk >> 3) * 4 + (c >> 5)) * 512 + ((kk & 7) * 32 + (c & 31)) * 2; }
__device__ __forceinline__ int v_rd_base(int lane) { return ((lane & 3) << 3) | (((lane >> 2) & 3) << 6) | (((lane >> 4) & 1) << 5) | (((lane >> 5) & 1) << 8); }
constexpr int v_rd_off(int d0, int ks, int half) { return d0 * 512 + ks * 4096 + half * 2048; }
template <int OFF> __device__ __forceinline__ s16x4 tr_read(int vb) { return __builtin_amdgcn_ds_read_tr16_b64_v4i16((LAS s16x4*)(unsigned)(vb + OFF)); }
template <bool FIN, bool PRE, int DM, class Dma> __device__ __forceinline__ void region_qk(f32x16& ps0, f32x16& ps1, const char* Ks, const bf16x8* qr, const char* qslot, const int (&kb)[4],
                                                              f32x16& pf0, f32x16& pf1, float mreg, float alpha, float& l_reg, bf16x8 (&pa)[4], int vb, s16x4 (&l)[4], s16x4 (&h)[4], Dma&& dma) {
    bf16x8 kf[2][2], qf[2]; FinSt st;
#define QKT_RD(d_, B) do { const char* kp_ = Ks + kb[(d_) & 3] + ((d_) >> 2) * 128; kf[B][0] = *reinterpret_cast<const bf16x8*>(kp_); kf[B][1] = *reinterpret_cast<const bf16x8*>(kp_ + 32 * 384); \
        if constexpr ((d_) < 12 - NQL) qf[B] = qr[(d_) < 12 - NQL ? (d_) : 0]; else qf[B] = *reinterpret_cast<const bf16x8*>(qslot + ((d_) - (12 - NQL)) * 1024); } while (0)
    QKT_RD(0, 0);
    sfor<0, 12>([&](auto d_) { constexpr int d0 = decltype(d_)::value, cb = d0 & 1, nb = cb ^ 1;
        if constexpr (d0 < 11) QKT_RD(d0 + 1, nb);
        if constexpr (d0 == 0) ps0 = __builtin_amdgcn_mfma_f32_32x32x16_bf16(kf[cb][0], qf[cb], f32x16{}, 0, 0, 0);
        else ps0 = __builtin_amdgcn_mfma_f32_32x32x16_bf16(kf[cb][0], qf[cb], ps0, 0, 0, 0);
        if constexpr (FIN) fin_slice<2 * d0>(pf0, pf1, mreg, alpha, l_reg, st, pa);
        if constexpr (PRE && d0 >= 10) { constexpr int k = 2 * (d0 - 10); l[k] = tr_read<v_rd_off(0, k, 0)>(vb); h[k] = tr_read<v_rd_off(0, k, 1)>(vb); }
        __builtin_amdgcn_sched_group_barrier(0x100, 3, 0); __builtin_amdgcn_sched_group_barrier(0x8, 1, 0);
        SBAR();
        if constexpr (d0 == 0) ps1 = __builtin_amdgcn_mfma_f32_32x32x16_bf16(kf[cb][1], qf[cb], f32x16{}, 0, 0, 0);
        else ps1 = __builtin_amdgcn_mfma_f32_32x32x16_bf16(kf[cb][1], qf[cb], ps1, 0, 0, 0);
        if constexpr (FIN) fin_slice<2 * d0 + 1>(pf0, pf1, mreg, alpha, l_reg, st, pa);
        if constexpr (PRE && d0 >= 10) { constexpr int k = 2 * (d0 - 10) + 1; l[k] = tr_read<v_rd_off(0, k, 0)>(vb); h[k] = tr_read<v_rd_off(0, k, 1)>(vb); }
        if constexpr ((d0 & 1) == 0 && d0 < 10 && (DM == 1 || (DM == 2 && d0 >= 6))) dma(std::integral_constant<int, d0 / 2>{});
        __builtin_amdgcn_sched_group_barrier(0x8, 1, 0);
        SBAR();
    });
#undef QKT_RD
}
template <bool PSM, bool PRE> __device__ __forceinline__ void region_pv(f32x16* o, int vb, const bf16x8 (&pa)[4], f32x16& pn0, f32x16& pn1, float& m_reg, float& alpha, s16x4 (&l)[4], s16x4 (&h)[4]) {
    PsmSt st;
    if constexpr (!PRE) {
    l[0] = tr_read<v_rd_off(0, 0, 0)>(vb); h[0] = tr_read<v_rd_off(0, 0, 1)>(vb); l[1] = tr_read<v_rd_off(0, 1, 0)>(vb); h[1] = tr_read<v_rd_off(0, 1, 1)>(vb);
    l[2] = tr_read<v_rd_off(0, 2, 0)>(vb); h[2] = tr_read<v_rd_off(0, 2, 1)>(vb); l[3] = tr_read<v_rd_off(0, 3, 0)>(vb); h[3] = tr_read<v_rd_off(0, 3, 1)>(vb);
    SBAR(); }
    sfor<0, 16>([&](auto n_) { constexpr int n = decltype(n_)::value, b = n >> 2, k = n & 3;
        o[b] = __builtin_amdgcn_mfma_f32_32x32x16_bf16(pa[k], (bf16x8){l[k][0], l[k][1], l[k][2], l[k][3], h[k][0], h[k][1], h[k][2], h[k][3]}, o[b], 0, 0, 0);
        if constexpr (b < 3) { l[k] = tr_read<v_rd_off((b + 1) & 3, k, 0)>(vb); h[k] = tr_read<v_rd_off((b + 1) & 3, k, 1)>(vb); }
        if constexpr (PSM) psm_slice<n>(pn0, pn1, m_reg, alpha, st);
        __builtin_amdgcn_sched_group_barrier(0x8, 1, 0); __builtin_amdgcn_sched_group_barrier(0x100, 2, 0);
        SBAR();
    });
}
__device__ __forceinline__ void finishSM(f32x16& p0, f32x16& p1, float mreg, float alpha, float& l_reg, bf16x8 (&pa)[4]) { FinSt st; sfor<0, 23>([&](auto m_) { fin_slice<decltype(m_)::value>(p0, p1, mreg, alpha, l_reg, st, pa); }); }
__device__ __forceinline__ void mask_48(f32x16& p0, f32x16& p1) {
#pragma unroll
    for (int r = 0; r < 16; ++r) p0[r] = -INFINITY;
#pragma unroll
    for (int r = 0; r < 8; ++r) p1[r] = -INFINITY;
}
__device__ __forceinline__ void glds16(const void* gsrc, unsigned lds_dst) { unsigned keep;
    asm volatile("s_mov_b32 %0, m0\n\ts_mov_b32 m0, %2\n\ts_nop 0\n\tglobal_load_lds_dwordx4 %1, off\n\ts_mov_b32 m0, %0" : "=&s"(keep) : "v"(gsrc), "s"(lds_dst) : "memory"); }
#define WAITV(N) asm volatile("s_waitcnt vmcnt(" #N ")" ::: "memory")
#define LBAR() asm volatile("s_waitcnt lgkmcnt(0)\n\ts_barrier" ::: "memory")
__device__ __forceinline__ void attn_unit(const bf16_t* __restrict__ Qs, const bf16_t* __restrict__ Kn, const bf16_t* __restrict__ Kr, const bf16_t* __restrict__ Vs, bf16_t* Os, int q0, int Lp, char* lds, const int tid) {
    const int wid = tid >> 6, lane = tid & 63, r32 = lane & 31, hi = lane >> 5; const int wu = __builtin_amdgcn_readfirstlane(wid);
    char* V_lds = lds; char* K_lds = lds + 2 * SHM_V;
    float* ws = (float*)(lds + 2 * SHM_V + 2 * SHM_K) + wid * 64; float* li_l = ws; float* al_l = ws + 32;
    float m_reg = -1e30f, l_reg = 0; f32x16 o[4] = {}; bf16x8 qr[12 - NQL];
    char* qslot = lds + SHM_QR + wid * (NQL * 1024) + lane * 16;
    int kb[4];
#pragma unroll
    for (int c = 0; c < 4; ++c) kb[c] = KSWZ(r32, c * 32 + hi * 16);
    const bf16_t* ksrc[3];
#pragma unroll
    for (int n = 0; n < 3; ++n) { const int p = (wid * 3 + n) * 64 + lane, row = p / 24, cp = p % 24, c = (cp & 24) | ((cp ^ row) & 7);
        ksrc[n] = c < 16 ? Kn + (size_t)row * 2048 + c * 8 : Kr + (size_t)row * 64 + (c - 16) * 8; }
    unsigned vsrc[2];
#pragma unroll
    for (int n = 0; n < 2; ++n) { const int p = (wid * 2 + n) * 64 + lane, sub = p >> 5, elt = (p & 31) * 8, kk = (sub >> 2) * 8 + (elt >> 5), k = (kk & ~0xC) | ((kk & 4) << 1) | ((kk & 8) >> 1), c = (sub & 3) * 32 + (elt & 31);
        vsrc[n] = (unsigned)(k * 2048 + c) * 2u; }
    const unsigned lK = (unsigned)(uintptr_t)K_lds + wu * 3072, lV = (unsigned)(uintptr_t)V_lds + wu * 2048;
    bool krope[3];
#pragma unroll
    for (int n = 0; n < 3; ++n) { const int p = (wid * 3 + n) * 64 + lane, row = p / 24, cp = p % 24, c = (cp & 24) | ((cp ^ row) & 7); krope[n] = c >= 16; }
#define DMA_K(t, b) do { _Pragma("unroll") for (int n_ = 0; n_ < 3; ++n_) glds16(ksrc[n_] + (size_t)(t) * (krope[n_] ? KVBLK * 64 : KVBLK * 2048), lK + (b) * SHM_K + n_ * 1024); } while (0)
#define DMA_V(t, b) do { const bf16_t* vt_ = Vs + (size_t)(t) * KVBLK * 2048; _Pragma("unroll") for (int n_ = 0; n_ < 2; ++n_) rscan::glds16u(vt_, vsrc[n_], lV + (b) * SHM_V + n_ * 1024); } while (0)
    DMA_K(1, 1); DMA_V(0, 0);
    const bf16_t* Qw = Qs + (size_t)(q0 + wid * QBLK + r32) * 3072 + hi * 8;
#pragma unroll
    for (int d0 = 0; d0 < 12 - NQL; ++d0) qr[d0] = *reinterpret_cast<const bf16x8*>(Qw + d0 * 16);
#pragma unroll
    for (int d0 = 12 - NQL; d0 < 12; ++d0) *reinterpret_cast<bf16x8*>(qslot + (d0 - (12 - NQL)) * 1024) = *reinterpret_cast<const bf16x8*>(Qw + d0 * 16);
    const int vb0 = (int)(uintptr_t)V_lds + v_rd_base(lane);
#define RESC(a) do { if (__any((a) < 1.f)) { if (hi == 0) al_l[r32] = (a); asm volatile("s_waitcnt lgkmcnt(0)" ::: "memory"); \
    _Pragma("unroll") for (int d = 0; d < 4; ++d) _Pragma("unroll") for (int r = 0; r < 16; ++r) o[d][r] *= al_l[crow(r, hi)]; } } while (0)
    f32x16 pA0, pA1, pB0, pB1; float alA = 1.f, alB; bf16x8 pa[4]; s16x4 vl[4], vh[4]; const int NT = Lp / KVBLK;
    static_assert(PADF >= KVBLK && PADF < 2 * KVBLK, "tile 0 fully masked, tile 1 partly");
#define DMA_FN(KT, KB, VT, VBUF) [&](auto pc_) { constexpr int pc = decltype(pc_)::value; \
        if constexpr (pc < 3) glds16(ksrc[pc] + (size_t)(KT) * (krope[pc] ? KVBLK * 64 : KVBLK * 2048), lK + (KB) * SHM_K + pc * 1024); \
        else rscan::glds16u(Vs + (size_t)(VT) * KVBLK * 2048, vsrc[pc - 3], lV + (VBUF) * SHM_V + (pc - 3) * 1024); }
    pA0 = f32x16{};
#pragma unroll
    for (int r = 0; r < 16; ++r) pA1[r] = -INFINITY;
    WAITV(0); LBAR();
    for (int j = 1; j + 1 < NT; j += 2) {
        SBAR(); region_qk<true, true, 1>(pB0, pB1, K_lds + SHM_K, qr, qslot, kb, pA0, pA1, m_reg, alA, l_reg, pa, vb0, vl, vh, DMA_FN(j + 1, 0, j, 1));
        if (j == 1) { asm volatile("" ::: "memory"); mask_48(pB0, pB1); }
        region_pv<true, true>(o, vb0, pa, pB0, pB1, m_reg, alB, vl, vh); PIN2(pB0, pB1);
        RESC(alB);
        WAITV(0); LBAR();
        SBAR(); region_qk<true, true, 1>(pA0, pA1, K_lds, qr, qslot, kb, pB0, pB1, m_reg, alB, l_reg, pa, vb0 + SHM_V, vl, vh, DMA_FN(j + 2, 1, j + 1, 0));
        region_pv<true, true>(o, vb0 + SHM_V, pa, pA0, pA1, m_reg, alA, vl, vh); PIN2(pA0, pA1);
        RESC(alA);
        WAITV(0); LBAR();
    }
    SBAR(); region_qk<true, true, 2>(pB0, pB1, K_lds + SHM_K, qr, qslot, kb, pA0, pA1, m_reg, alA, l_reg, pa, vb0, vl, vh, DMA_FN(0, 0, NT - 1, 1));
    region_pv<true, true>(o, vb0, pa, pB0, pB1, m_reg, alB, vl, vh); PIN2(pB0, pB1);
    RESC(alB);
    WAITV(0); LBAR();
    finishSM(pB0, pB1, m_reg, alB, l_reg, pa); SBAR();
    region_pv<false, false>(o, vb0 + SHM_V, pa, pB0, pB1, m_reg, alB, vl, vh);
#undef DMA_FN
    if (hi == 0) li_l[r32] = l_reg; asm volatile("s_waitcnt lgkmcnt(0)" ::: "memory");
    float rli[16];
#pragma unroll
    for (int r = 0; r < 16; ++r) rli[r] = __builtin_amdgcn_rcpf(li_l[crow(r, hi)]);
#pragma unroll
    for (int r = 0; r < 16; ++r) { const int rs = q0 + wid * QBLK + crow(r, hi);
        if (rs < Lp) { const float keep = rs >= PADF ? rli[r] : 0.f; bf16_t* orow = Os + (size_t)rs * 2048;
#pragma unroll
            for (int d0 = 0; d0 < 4; ++d0) orow[d0 * 32 + r32] = (bf16_t)(cvt_pk_bf16(o[d0][r] * keep, 0.f) & 0xffffu); } }
    LBAR();
#undef DMA_K
#undef DMA_V
#undef RESC
}
__device__ __forceinline__ void attn_phase(const Frame& F, const bf16_t* Q, const bf16_t* KN, const bf16_t* KR, const bf16_t* V, bf16_t* O) {
    constexpr int NQP = (LP_P + 255) / 256, NQS = (LP_S + 255) / 256, NUP = NP * MH * NQP  , NUS = NS * MH * NQS  ;
    const int c = F.vcu; const bool exact = (F.G == 256);
    const int np = exact ? (c < 64 ? 9 : 8) : (NUP - c + F.G - 1) / F.G, ns = exact ? (c < 64 ? 7 : 9) : 0;
    const int ntot = exact ? np + ns : (NUP + NUS - c + F.G - 1) / F.G;
    for (int i = 0; i < ntot; ++i) {
        int u; bool smp;
        if (exact) { smp = i >= np; u = !smp ? (i < 8 ? c + 256 * i : 2048 + c) : (c < 64 ? c + 64 * (i - np) : 448 + (c - 64) + 192 * (i - np)); }
        else { const int g = c + F.G * i; smp = g >= NUP; u = smp ? g - NUP : g; }
        const int nqb = smp ? NQS : NQP, Lp = smp ? LP_S : LP_P;
        const int qb = u % nqb, sh = u / nqb, head = sh % MH, seq = sh / MH; const size_t rb = (smp ? (size_t)ROWS0 : 0) + (size_t)seq * Lp;
        attn_unit(Q + rb * 3072 + head * MQK, KN + rb * 2048 + head * MNOPE, KR + rb * 64, V + rb * 2048 + head * MV, O + rb * 2048 + head * MV, qb * 256, Lp, F.ldsg, F.tid);
    }
}
#undef KSWZ
#undef SBAR
}

__device__ __forceinline__ int hw_lane() { unsigned m_ = ~0u; asm volatile("" : "+s"(m_)); return (int)__builtin_amdgcn_mbcnt_hi(m_, __builtin_amdgcn_mbcnt_lo(m_, 0u)); }
constexpr int NWAVES = 8;
constexpr int N_PHASES = 2 * (1 + 11 + 1 + 3) + 2 * (1 + 5 + 1 + 3) + 1;
__global__ void __launch_bounds__(NWAVES * 64, 2) mk_fwd(Args args) {
    extern __shared__ __attribute__((aligned(16))) unsigned char lds[];
    Frame F;
    F.lds = (LAS unsigned char*)lds; F.ldsg = (char*)lds;
    F.tid = threadIdx.x; F.lane = F.tid & 63; F.wave = __builtin_amdgcn_readfirstlane(F.tid >> 6); const int wave0 = F.wave;
    F.G = gridDim.x; { const int bx = blockIdx.x; F.vcu = (F.G % 8 == 0) ? (bx % 8) * (F.G / 8) + bx / 8 : bx; }
    F.gw = F.vcu * NWAVES + F.wave; F.NGW = F.G * NWAVES; { int z_ = 0; asm volatile("" : "+v"(z_)); F.zero = z_; }
    volatile LAS unsigned* MISC = (volatile LAS unsigned*)(F.lds + MISC_OFF);
    if (F.tid < 64) MISC[F.tid] = 0u;
    { const __attribute__((address_space(4))) unsigned* kp = (const __attribute__((address_space(4))) unsigned*)__builtin_amdgcn_kernarg_segment_ptr();
      if (F.tid < (int)(sizeof(Args) / 4)) ((LAS unsigned*)(F.lds + ARGS_OFF))[F.tid] = kp[F.tid]; }
    __syncthreads();
    const int lo = args.ph_lo, hi = args.ph_hi;
    XcdBarrier bar = xcd_barrier_post((unsigned*)(arg_ws(F) + WS_CTL) + 4096, MISC + 8);
    int ph = 0;
#define PH_ON (ph >= lo && ph < hi)
#define HW_TID() (wave0 * 64 + hw_lane())
#define PH_END do { if (ph >= lo && ph + 1 < hi) xcd_barrier(bar, HW_TID() == 0); ++ph; } while (0)
#define FRESH() Frame Fp = F; { int t_ = HW_TID(); asm volatile("" : "+v"(t_)); Fp.tid = t_; Fp.lane = t_ & 63; Fp.wave = __builtin_amdgcn_readfirstlane(t_ >> 6); int v_ = F.vcu; asm volatile("" : "+s"(v_)); Fp.vcu = v_; Fp.gw = v_ * NWAVES + Fp.wave; int z_ = 0; asm volatile("" : "+v"(z_)); Fp.zero = z_; }
#define WSP(off) (arg_ws(F) + (off))
#define OBP(off) (arg_out(Fp) + (off))

    for (int L = 0; L < DEPTH; ++L) {
        if (PH_ON && EN_PREP) { FRESH();
            if (L == 0) { tables_phase(Fp); embed_phase(Fp); }
            else rowstat_phase(Fp);
            convert_phase(Fp, L, (L == 0 || F.G != 256) ? 0 : 2);
        }
        PH_END;
        if ((L & 1) == 0) {
            for (int half = 0; half < 2; ++half) {
                const int row0 = half ? ROWS0 : 0, rows = half ? ROWS1 : ROWS0;
                if (PH_ON && EN_G1) { FRESH();
                    unsigned char* ws = arg_ws(Fp);
                    pg8::Gemm g{(const bf16_t*)(ws + WS_H) + (size_t)row0 * D, (const bf16_t*)(ws + WS_W + W_RQKV), rows, 8192, D, D, D}; pg8::StaticOrder S; S.init(rows, 8192, F.G, (int)blockIdx.x);
                    pg8::EpiRetQKV E{(bf16_t*)OBP(O_RQ), (bf16_t*)(ws + WS_S + S_RK), (bf16_t*)(ws + WS_S + S_RV), (const float*)(ws + TAB_COSR), (const float*)(ws + TAB_SINR), row0, (const float*)(ws + WS_RSTD) + row0};
                    _Pragma("unroll") for (int rp = 0; rp < REP_GEMM; ++rp) pg8::gemm_phase<pg8::EpiRetQKV, pg8::StaticOrder, true, true>(Fp.lds, g, S, E, Fp.tid);
                }
                PH_END;
                if (PH_ON && EN_SCAN) { FRESH(); unsigned char* ws = arg_ws(Fp);
                    rscan::pmat_phase(Fp, (const bf16_t*)OBP(O_RQ), (const bf16_t*)(ws + WS_S + S_RK), (bf16_t*)OBP(O_RP), half); }
                PH_END;
                if (PH_ON && EN_SCAN) { FRESH(); unsigned char* ws = arg_ws(Fp);
                    for (int rp = 0; rp < REP_SCAN; ++rp) rscan::scan_phase(Fp, (const bf16_t*)OBP(O_RQ), (const bf16_t*)(ws + WS_S + S_RK), (const bf16_t*)(ws + WS_S + S_RV), (const bf16_t*)OBP(O_RP), (bf16_t*)(ws + WS_S + S_ROF), (bf16_t*)OBP(O_ROB), half); }
                PH_END;
                if (PH_ON && EN_G2) { FRESH();
                    unsigned char* ws = arg_ws(Fp);
                    pg8::Gemm g{(const bf16_t*)(ws + WS_H) + (size_t)row0 * D, (const bf16_t*)(ws + WS_W + W_RG), rows, 4096, D, D, D}; pg8::StaticOrder S; S.init(rows, 4096, F.G, (int)blockIdx.x);
                    pg8::EpiStore<0> E{(bf16_t*)(ws + WS_S + S_RV), 4096, 0, nullptr, (const float*)(ws + WS_RSTD) + row0};
                    _Pragma("unroll") for (int rp = 0; rp < REP_GEMM; ++rp) pg8::gemm_phase<pg8::EpiStore<0>, pg8::StaticOrder, true, true>(Fp.lds, g, S, E, Fp.tid);
                }
                PH_END;
                if (PH_ON && EN_MISC) { FRESH(); unsigned char* ws = arg_ws(Fp); ret_combine_phase(Fp, (const bf16_t*)(ws + WS_S + S_ROF), (const bf16_t*)OBP(O_ROB), (const bf16_t*)(ws + WS_S + S_RV), half ? (bf16_t*)(ws + WS_S + S_ROF) : (bf16_t*)(ws + WS_A), rows); }
                PH_END;
            }
            if (PH_ON && EN_G4) { FRESH();
                for (int hh = 0; hh < 2; ++hh) {
                    unsigned char* ws = arg_ws(Fp); const int rows = hh ? ROWS1 : ROWS0;
                    pg8::Gemm g{hh ? (const bf16_t*)(ws + WS_S + S_ROF) : (const bf16_t*)(ws + WS_A), (const bf16_t*)(ws + WS_W + W_RO), rows, D, 4096, 4096, 4096};
                    pg8::StaticOrder S; S.init(rows, D, F.G, (int)((blockIdx.x + (hh ? 128 : 0)) % F.G));
                    pg8::EpiRes E{(bf16_t*)(ws + WS_H) + (size_t)(hh ? ROWS0 : 0) * D, D, 0};
                    pg8::gemm_phase<pg8::EpiRes, pg8::StaticOrder, true, true>(Fp.lds, g, S, E, Fp.tid);
                }
            }
            PH_END;
        } else {
            if (PH_ON && EN_G2) { FRESH();
                unsigned char* ws = arg_ws(Fp);
                pg8::Gemm g{(const bf16_t*)(ws + WS_H), (const bf16_t*)(ws + WS_W + W_MA), MT, MA_N, D, D, D}; pg8::StaticOrder S; S.init(MT, MA_N, F.G, (int)blockIdx.x);
                pg8::EpiStore<0> E{(bf16_t*)OBP(O_MCQKV), MA_N, 0, nullptr, (const float*)(ws + WS_RSTD)};
                _Pragma("unroll") for (int rp = 0; rp < REP_GEMM; ++rp) pg8::gemm_phase<pg8::EpiStore<0>, pg8::StaticOrder, true, true>(Fp.lds, g, S, E, Fp.tid);
            }
            PH_END;
            if (PH_ON && EN_MISC) { FRESH(); unsigned char* ws = arg_ws(Fp); for (int rp = 0; rp < REP_MISC; ++rp) mla_rowpass_phase(Fp, L >> 1, (const bf16_t*)OBP(O_MCQKV), (bf16_t*)(ws + WS_A + X_MCN), (bf16_t*)OBP(O_MKR), MT, 0); }
            PH_END;
            if (PH_ON && EN_G3) { FRESH();
                { unsigned char* ws = arg_ws(Fp);
                  pg8::Gemm g{(const bf16_t*)(ws + WS_A + X_MCN), (const bf16_t*)(ws + WS_W + W_MQB), MT, 3072, 512, 1024, 512}; pg8::StaticOrder S; S.init(MT, 3072, F.G, (int)blockIdx.x);
                  pg8::EpiMlaQ E{(bf16_t*)(ws + WS_S + S_MQ), (const float*)(ws + TAB_COSM), (const float*)(ws + TAB_SINM), 0};
                  _Pragma("unroll") for (int rp = 0; rp < REP_GEMM; ++rp) pg8::gemm_phase<pg8::EpiMlaQ, pg8::StaticOrder, true, true>(Fp.lds, g, S, E, Fp.tid); }
                { unsigned char* ws = arg_ws(Fp);
                  pg8::Gemm g{(const bf16_t*)(ws + WS_A + X_MCN) + 512, (const bf16_t*)(ws + WS_W + W_MKVB), MT, 4096, 512, 1024, 512}; pg8::StaticOrder S; S.init(MT, 4096, F.G, (int)((blockIdx.x + 128) % F.G));
                  pg8::EpiStore<0> E{(bf16_t*)(ws + WS_S + S_MKN), 2048, 2048, (bf16_t*)OBP(O_MV), nullptr};
                  _Pragma("unroll") for (int rp = 0; rp < REP_GEMM; ++rp) pg8::gemm_phase<pg8::EpiStore<0>, pg8::StaticOrder, true, true>(Fp.lds, g, S, E, Fp.tid); }
            }
            PH_END;
            if (PH_ON && EN_ATTN) { FRESH(); unsigned char* ws = arg_ws(Fp);
                for (int rp = 0; rp < REP_ATTN; ++rp) mattn::attn_phase(Fp, (const bf16_t*)(ws + WS_S + S_MQ), (const bf16_t*)(ws + WS_S + S_MKN), (const bf16_t*)OBP(O_MKR), (const bf16_t*)OBP(O_MV), (bf16_t*)(ws + WS_A + X_MO)); }
            PH_END;
            if (PH_ON && EN_G4) { FRESH();
                unsigned char* ws = arg_ws(Fp);
                pg8::Gemm g{(const bf16_t*)(ws + WS_A + X_MO), (const bf16_t*)(ws + WS_W + W_MO), MT, D, D, D, D}; pg8::StaticOrder S; S.init(MT, D, F.G, (int)blockIdx.x);
                _Pragma("unroll") for (int rp = 0; rp < REP_GEMM; ++rp) { pg8::EpiRes E{(bf16_t*)(ws + WS_H), D, rp};
                pg8::gemm_phase<pg8::EpiRes, pg8::StaticOrder, true, true>(Fp.lds, g, S, E, Fp.tid); }
            }
            PH_END;
        }
        if (PH_ON && EN_PREP) { FRESH(); for (int rp = 0; rp < REP_MISC; ++rp) norm_phase(Fp, arg_in(Fp, 4) + (size_t)L * D); }
        PH_END;
        if (PH_ON && EN_M1) { FRESH();
            unsigned char* ws = arg_ws(Fp);
            pg8::Gemm g{(const bf16_t*)(ws + WS_A), (const bf16_t*)(ws + WS_W + W_1), MT, FFA, D, D, D}; pg8::StaticOrder S; S.init(MT, FFA, F.G, (int)blockIdx.x);
            pg8::EpiStore<1> E{(bf16_t*)(ws + WS_S + S_HID), FFA, 0, nullptr, nullptr};
            pg8::gemm_phase<pg8::EpiStore<1>, pg8::StaticOrder, true, true>(Fp.lds, g, S, E, Fp.tid);
        }
        PH_END;
        if (PH_ON && EN_M2) { FRESH();
            { unsigned char* ws = arg_ws(Fp);
              pg8::Gemm g{(const bf16_t*)(ws + WS_S + S_HID), (const bf16_t*)(ws + WS_W + W_2), MT, D, FFA, FFA, FF}; pg8::StaticOrder S; S.init(MT, D, F.G, (int)blockIdx.x);
              pg8::EpiRes E{(bf16_t*)(ws + WS_H), D, 0};
              pg8::gemm_phase<pg8::EpiRes, pg8::StaticOrder, true, true>(Fp.lds, g, S, E, Fp.tid); }
            { unsigned char* ws = arg_ws(Fp);
              pg8::Gemm g{(const bf16_t*)(ws + WS_A), (const bf16_t*)(ws + WS_W + W_1) + (size_t)FFA * D, MT, FFB, D, D, D}; pg8::UpBOrder S; S.init(MT, FFB, F.G, (int)blockIdx.x);
              pg8::EpiStore<1> E{(bf16_t*)OBP(O_HID), FFB, 0, nullptr, nullptr};
              pg8::gemm_phase<pg8::EpiStore<1>, pg8::UpBOrder, true, true>(Fp.lds, g, S, E, Fp.tid); }
        }
        PH_END;
        if (PH_ON && EN_M2) { FRESH();
            unsigned char* ws = arg_ws(Fp);
            pg8::Gemm g{(const bf16_t*)OBP(O_HID), (const bf16_t*)(ws + WS_W + W_2) + FFA, MT, D, FFB, FFB, FF}; pg8::StaticOrder S; S.init(MT, D, F.G, (int)blockIdx.x);
            pg8::EpiRes E{(bf16_t*)(ws + WS_H), D, 0};
            pg8::gemm_phase<pg8::EpiRes, pg8::StaticOrder, true, true>(Fp.lds, g, S, E, Fp.tid);
            if (F.G == 256 && L + 1 < DEPTH && blockIdx.x >= 48) { Frame Ff = Fp; Ff.gw = ((int)blockIdx.x - 48) * NWAVES + Fp.wave; Ff.NGW = 208 * NWAVES; convert_phase(Ff, L + 1, 1); }
        }
        PH_END;
    }
    if (PH_ON && EN_PREP) { FRESH(); final_phase(Fp); }
    PH_END;
#undef PH_ON
#undef PH_END
#undef FRESH
#undef WSP
#undef OBP
}

extern "C" void kernel_launch(void* const* d_in, const int* in_sizes, int n_in, void* d_out, int out_size, void* d_ws, size_t ws_size, hipStream_t stream) {
    static int grid = 0;
    if (grid == 0) {
        if (n_in != 20 || ws_size < WS_NEED) { fprintf(stderr, "kernel_launch: n_in %d ws %zu (need %zu)\n", n_in, ws_size, (size_t)WS_NEED); grid = -1; return; }
        int dev = 0, cus = 0, per_cu = 0;
        if (hipGetDevice(&dev) != hipSuccess || hipDeviceGetAttribute(&cus, hipDeviceAttributeMultiprocessorCount, dev) != hipSuccess) { grid = -1; return; }
        if (hipFuncSetAttribute((const void*)mk_fwd, hipFuncAttributeMaxDynamicSharedMemorySize, LDS_BYTES) != hipSuccess) { fprintf(stderr, "kernel_launch: hipFuncSetAttribute failed\n"); grid = -1; return; }
        if (hipOccupancyMaxActiveBlocksPerMultiprocessor(&per_cu, (const void*)mk_fwd, NWAVES * 64, LDS_BYTES) != hipSuccess || per_cu < 1) { fprintf(stderr, "kernel_launch: occupancy query says %d\n", per_cu); }
        (void)hipGetLastError();
        grid = cus;
    }
    if (grid < 0) return;
    (void)hipMemsetAsync((char*)d_ws + WS_CTL, 0, CTL_ZERO_BYTES, stream);
    Args a{};
    for (int i = 0; i < 20; ++i) a.in[i] = (const float*)d_in[i];
    a.out = (float*)d_out; a.ws = (unsigned char*)d_ws;
    for (int j = 0; j < 128; ++j) a.inv_ret[j] = (float)(1.0 / pow(10000.0, (double)(2 * j) / 256.0));
    for (int j = 0; j < 32; ++j) a.inv_mla[j] = (float)(1.0 / pow(10000.0, (double)(2 * j) / 64.0));
    for (int h = 0; h < 8; ++h) { a.lg2[h] = (float)log2(1.0 - pow(2.0, -5.0 - h)); a.lg2[8 + h] = (float)log2(1.0 - pow(2.0, -5.5 - h)); }
#if MK_PER_PHASE_LAUNCH
    for (int p = 0; p < N_PHASES; ++p) { a.ph_lo = p; a.ph_hi = p + 1; hipLaunchKernelGGL(mk_fwd, dim3(grid), dim3(NWAVES * 64), LDS_BYTES, stream, a); }
#else
    a.ph_lo = 0; a.ph_hi = N_PHASES;
    hipLaunchKernelGGL(mk_fwd, dim3(grid), dim3(NWAVES * 64), LDS_BYTES, stream, a);
#endif
    const hipError_t le = hipPeekAtLastError();
    if (le != hipSuccess) fprintf(stderr, "kernel_launch: launch failed: %s\n", hipGetErrorName(le));
}
```

```cpp
#include <hip/hip_runtime.h>
#include <cstdio>
#include <cstdint>
#include <cmath>
#include <type_traits>

#ifndef MK_PER_PHASE_LAUNCH
#define MK_PER_PHASE_LAUNCH 0
#endif
#ifndef EN_SCAN
#define EN_SCAN 1
#endif
#ifndef EN_ATTN
#define EN_ATTN 1
#endif
#ifndef EN_MISC
#define EN_MISC 1
#endif
#ifndef EN_G1
#define EN_G1 1
#endif
#ifndef EN_G2
#define EN_G2 1
#endif
#ifndef EN_G3
#define EN_G3 1
#endif
#ifndef EN_G4
#define EN_G4 1
#endif
#ifndef EN_PREP
#define EN_PREP 1
#endif
#ifndef EN_M1
#define EN_M1 1
#endif
#ifndef EN_M2
#define EN_M2 1
#endif
#ifndef REP_GEMM
#define REP_GEMM 1
#endif
#ifndef REP_ATTN
#define REP_ATTN 1
#endif
#ifndef REP_SCAN
#define REP_SCAN 1
#endif
#ifndef REP_MISC
#define REP_MISC 1
#endif
#ifndef MK_DEBUG_CHECK
#define MK_DEBUG_CHECK 0
#endif

constexpr int D = 2048, FF = 8192, DEPTH = 4;
constexpr int PADF = 112, NMETA = 16;
constexpr int NP = 4, NS = 8, SP = 8192, SS = 4096;
constexpr int LP_P = PADF + NMETA + SP  , LP_S = PADF + NMETA + SS  ;
constexpr int ROWS0 = NP * LP_P  , ROWS1 = NS * LP_S  , MT = ROWS0 + ROWS1  ;
constexpr int LMAX = NMETA + SP;
constexpr float NORM_EPS = 1e-6f;
constexpr int RH = 8, RDK = 256, RDV = 512;
constexpr int MH = 16, MQL = 512, MKVL = 512, MNOPE = 128, MROPE = 64, MV = 128, MQK = MNOPE + MROPE;
constexpr int FFA = 4352, FFB = FF - FFA;
static_assert(ROWS0 % 256 == 0 && ROWS1 % 256 == 0, "halves are whole 256-row tiles");

constexpr size_t MiB = 1u << 20;
constexpr size_t WS_CTL = 0, CTL_ZERO_BYTES = 65536;
constexpr size_t TAB_COSR = 1 * MiB, TAB_R_BYTES = (size_t)LMAX * 128 * 4, TAB_SINR = TAB_COSR + TAB_R_BYTES;
constexpr size_t TAB_COSM = TAB_SINR + TAB_R_BYTES, TAB_M_BYTES = (size_t)LMAX * 32 * 4, TAB_SINM = TAB_COSM + TAB_M_BYTES;
constexpr size_t WS_RSTD = 12 * MiB;
static_assert(TAB_SINM + TAB_M_BYTES <= WS_RSTD && WS_RSTD + (size_t)MT * 4 <= 13 * MiB, "tables");
constexpr size_t WS_H = 13 * MiB;
constexpr size_t WS_A = WS_H + 262 * MiB;
constexpr size_t WS_W = WS_A + 262 * MiB;
constexpr size_t WS_S = WS_W + 128 * MiB;
constexpr size_t WS_NEED = WS_S + 660 * MiB;
static_assert((size_t)MT * D * 2 == 262 * MiB, "h size");
constexpr size_t W_RQKV = 0, W_RG = 32 * MiB, W_RO = 48 * MiB;
constexpr size_t W_MA = 0, W_MQB = 5 * MiB, W_MKVB = 8 * MiB, W_MO = 12 * MiB;
constexpr size_t W_1 = 64 * MiB, W_2 = 96 * MiB;
constexpr size_t S_RV = 0, S_ROF = 264 * MiB, S_RK = 528 * MiB;
constexpr size_t O_ROB = 0, O_RQ = 264 * MiB, O_RP = 396 * MiB;
static_assert(O_RP + (size_t)(ROWS1 / 128) * RH * 32768 <= 512 * MiB, "P buffer");
constexpr size_t S_MQ = 0, S_MKN = 393 * MiB;
constexpr size_t O_MV = 0, O_MKR = 262 * MiB, O_MCQKV = 271 * MiB;
constexpr size_t X_MCN = 0, X_MO = 0;
static_assert(S_MKN + 262 * MiB <= 692 * MiB && O_MCQKV + (size_t)MT * 1280 * 2 <= 512 * MiB, "MLA buffers");
constexpr size_t O_PART = 496 * MiB;
static_assert(O_PART >= (size_t)MT * FFB * 2 && O_PART + (size_t)MT * 32 * 4 <= 512 * MiB, "row-statistics partials");
constexpr size_t S_HID = 0, O_HID = 0;
static_assert((size_t)MT * FFA * 2 <= 692 * MiB && (size_t)MT * FFB * 2 <= 512 * MiB && FFA % 256 == 0 && FFB % 256 == 0 && FFA % 128 == 0, "hidden parts fit");
constexpr int MA_N = 1280;

constexpr int RING_BYTES = 131072;
constexpr int LDS_BYTES = 147456;
constexpr int MISC_OFF = LDS_BYTES - 256;
constexpr int ARGS_OFF = LDS_BYTES - 1280;

#define GAS __attribute__((address_space(1)))
#define LAS __attribute__((address_space(3)))
typedef unsigned short bf16_t;
typedef short bf16x8 __attribute__((ext_vector_type(8)));
typedef short s16x4 __attribute__((ext_vector_type(4)));
typedef float f32x4 __attribute__((ext_vector_type(4)));
typedef float f32x16 __attribute__((ext_vector_type(16)));
typedef unsigned u32x4 __attribute__((ext_vector_type(4)));
typedef unsigned u32x2 __attribute__((ext_vector_type(2)));
typedef GAS unsigned gu32;

__device__ __forceinline__ unsigned cvt_pk_bf16(float lo, float hi) { unsigned r; asm volatile("v_cvt_pk_bf16_f32 %0, %1, %2" : "=v"(r) : "v"(lo), "v"(hi)); return r; }
__device__ __forceinline__ float bf_lo(unsigned w) { return __uint_as_float(w << 16); }
__device__ __forceinline__ float bf_hi(unsigned w) { return __uint_as_float(w & 0xffff0000u); }
__device__ __forceinline__ float bf2f(bf16_t b) { return __uint_as_float((unsigned)b << 16); }
template <int X> __device__ __forceinline__ float swz_xor(float v) { return __int_as_float(__builtin_amdgcn_ds_swizzle(__float_as_int(v), 0x1F | (X << 10))); }
__device__ __forceinline__ float wave_sum(float v) {
    v += swz_xor<1>(v); v += swz_xor<2>(v); v += swz_xor<4>(v); v += swz_xor<8>(v); v += swz_xor<16>(v);
    const auto rr = __builtin_amdgcn_permlane32_swap(__float_as_uint(v), __float_as_uint(v), false, false);
    return __uint_as_float(rr[0]) + __uint_as_float(rr[1]);
}
__device__ __forceinline__ int row_tpos(int grow) { const int rs = grow < ROWS0 ? grow % LP_P : (grow - ROWS0) % LP_S; return rs - PADF; }

namespace pg8 {
#define PG8_LAS __attribute__((address_space(3)))
constexpr int BM = 256, BK = 64, HALF = 128, HTB = HALF * BK * 2, STAGE_BYTES = 8 * HTB, NXCD = 8, WGM = 8;
__host__ __device__ __forceinline__ int lds_byte(int r, int c) { const int st = (r >> 4) * 2 + (c >> 5), rr = r & 15, cc = c & 31, ob = rr * 64 + cc * 2; return st * 1024 + (ob ^ (((ob >> 9) & 1) << 5)); }
__host__ __device__ __forceinline__ void stage_rc(int b, int& R, int& C) { const int st = b / 1024, sb = b % 1024, swz = sb ^ (((sb >> 9) & 1) << 5); R = (st >> 1) * 16 + swz / 64; C = (st & 1) * 32 + (swz % 64) / 2; }
__host__ __device__ __forceinline__ int perm32(int rho) { const int n = rho >> 4, i = rho & 15; return 8 * (i >> 2) + 4 * n + (i & 3); }
#ifndef WGM_SEL
#define WGM_SEL(nN) ((nN) >= 32 ? 8 : 4)
#endif
struct Unit { int pm, pn; };
struct Gemm { const bf16_t* A; const bf16_t* Bt; int M, N, K, lda, ldb; };
struct StaticOrder {
    int nM, nN, nwg, G, c, wgm;
    __host__ __device__ void init(int M, int N, int G_, int c_) { nM = M / BM; nN = N / BM; nwg = nM * nN; G = G_; c = c_; wgm = WGM_SEL(nN); }
    __host__ __device__ bool next(int i, Unit& u) const {
        const long L = (long)i * G + c; if (L >= nwg) return false;
        int wgid = (int)L; { const int q = nwg / NXCD, r = nwg % NXCD, xcd = wgid % NXCD, off = wgid / NXCD; wgid = (xcd < r ? xcd * (q + 1) : r * (q + 1) + (xcd - r) * q) + off; }
        const int nig = wgm * nN, gid = wgid / nig, fm = gid * wgm, gsz = (nM - fm) < wgm ? (nM - fm) : wgm;
        u.pm = fm + ((wgid % nig) % gsz); u.pn = (wgid % nig) / gsz; return true;
    }
    __device__ __forceinline__ void a_ready(const Unit&) const {}
    __device__ __forceinline__ void done(const Unit&) const {}
};

struct UpBOrder {
    StaticOrder S;
    __host__ __device__ void init(int M, int N, int G_, int c_) { S.init(M, N, G_, c_); }
    __host__ __device__ bool next(int i, Unit& u) const {
        if (S.G != 256 || S.nwg != 3930) return S.next(i, u);
        long L;
        if (i < 14) L = (long)i * 256 + S.c; else if (i == 14) { if (S.c < 48) return false; L = 3584 + (S.c - 48); } else if (i == 15) { if (S.c < 48 || S.c >= 186) return false; L = 3792 + (S.c - 48); } else return false;
        StaticOrder T = S; T.G = 1; T.c = 0; return T.next((int)L, u);
    }
    __device__ __forceinline__ void a_ready(const Unit&) const {}
    __device__ __forceinline__ void done(const Unit&) const {}
};

template <int ACT  > struct EpiStore {
    static constexpr bool PERM = true, AFTER_DRAIN = false;
    bf16_t* O; int ldc; int split_cols; bf16_t* O2; const float* rs;
    __device__ __forceinline__ void operator()(const f32x4 (&acc)[2][2][4][2], const Unit& u, int wr, int wc, int fr, int fq) const {
        const int row0 = u.pm * BM + wr * 64 + fr; int colt = u.pn * BM; bf16_t* base = O;
        if (split_cols && colt >= split_cols) { base = O2; colt -= split_cols; }
        const int col0 = colt + wc * 32 + 8 * fq;
        float rsv[2][4];
#pragma unroll
        for (int ai = 0; ai < 2; ++ai)
#pragma unroll
            for (int m = 0; m < 4; ++m) rsv[ai][m] = rs ? rs[row0 + ai * HALF + m * 16] : 1.f;
#pragma unroll
        for (int ai = 0; ai < 2; ++ai)
#pragma unroll
            for (int m = 0; m < 4; ++m) { bf16_t* rowp = base + (size_t)(row0 + ai * HALF + m * 16) * ldc + col0;
                const float rsc = rsv[ai][m];
#pragma unroll
                for (int bj = 0; bj < 2; ++bj) { f32x4 v0 = acc[ai][bj][m][0] * rsc, v1 = acc[ai][bj][m][1] * rsc;
                    if (ACT == 1) {
#pragma unroll
                        for (int e = 0; e < 4; ++e) { const float a = fmaxf(v0[e], 0.f), b = fmaxf(v1[e], 0.f); v0[e] = a * a; v1[e] = b * b; } }
                    u32x4 w; w.x = cvt_pk_bf16(v0[0], v0[1]); w.y = cvt_pk_bf16(v0[2], v0[3]); w.z = cvt_pk_bf16(v1[0], v1[1]); w.w = cvt_pk_bf16(v1[2], v1[3]);
                    *(u32x4*)(rowp + bj * HALF) = w; } }
    }
};
struct EpiRes {
    static constexpr bool PERM = true, AFTER_DRAIN = false;
    bf16_t* H; int ldc; int dry; float* part;
    __device__ __forceinline__ void operator()(const f32x4 (&acc)[2][2][4][2], const Unit& u, int wr, int wc, int fr, int fq) const {
        const int row0 = u.pm * BM + wr * 64 + fr; const int col0 = u.pn * BM + wc * 32 + 8 * fq;
        u32x4 ov[2][4][2];
#pragma unroll
        for (int ai = 0; ai < 2; ++ai)
#pragma unroll
            for (int m = 0; m < 4; ++m) { const bf16_t* rowp = H + (size_t)(row0 + ai * HALF + m * 16) * ldc + col0;
#pragma unroll
                for (int bj = 0; bj < 2; ++bj) ov[ai][m][bj] = *(const u32x4*)(rowp + bj * HALF); }
#pragma unroll
        for (int ai = 0; ai < 2; ++ai)
#pragma unroll
            for (int m = 0; m < 4; ++m) { bf16_t* rowp = H + (size_t)(row0 + ai * HALF + m * 16) * ldc + col0;
                float sq = 0.f;
#pragma unroll
                for (int bj = 0; bj < 2; ++bj) { const f32x4 v0 = acc[ai][bj][m][0], v1 = acc[ai][bj][m][1];
                    const u32x4 o = ov[ai][m][bj]; u32x4 w;
                    w.x = cvt_pk_bf16(bf_lo(o.x) + v0[0], bf_hi(o.x) + v0[1]); w.y = cvt_pk_bf16(bf_lo(o.y) + v0[2], bf_hi(o.y) + v0[3]);
                    w.z = cvt_pk_bf16(bf_lo(o.z) + v1[0], bf_hi(o.z) + v1[1]); w.w = cvt_pk_bf16(bf_lo(o.w) + v1[2], bf_hi(o.w) + v1[3]);
                    if (part) {
#pragma unroll
                        for (int e = 0; e < 4; ++e) { const float x = bf_lo(w[e]), y = bf_hi(w[e]); sq += x * x + y * y; } }
                    if (!dry) *(u32x4*)(rowp + bj * HALF) = w; }
                if (part) {
                    sq += swz_xor<16>(sq); const auto rr = __builtin_amdgcn_permlane32_swap(__float_as_uint(sq), __float_as_uint(sq), false, false); sq = __uint_as_float(rr[0]) + __uint_as_float(rr[1]);
                    if (fq == 0) part[(size_t)(row0 + ai * HALF + m * 16) * 32 + u.pn * 4 + wc] = sq; } }
    }
};
struct EpiRetQKV {
    static constexpr bool PERM = true, AFTER_DRAIN = false;
    bf16_t *Q, *K, *V; const float* cosT; const float* sinT; int grow0; const float* rs;
    __device__ __forceinline__ void operator()(const f32x4 (&acc)[2][2][4][2], const Unit& u, int wr, int wc, int fr, int fq) const {
        const int row0 = u.pm * BM + wr * 64 + fr;
        if (u.pn >= 16) {
            const int col0 = (u.pn - 16) * BM + wc * 32 + 8 * fq;
            float rsv[2][4];
#pragma unroll
            for (int ai = 0; ai < 2; ++ai)
#pragma unroll
                for (int m = 0; m < 4; ++m) rsv[ai][m] = rs[row0 + ai * HALF + m * 16];
#pragma unroll
            for (int ai = 0; ai < 2; ++ai)
#pragma unroll
                for (int m = 0; m < 4; ++m) { bf16_t* rowp = V + (size_t)(row0 + ai * HALF + m * 16) * 4096 + col0; const float rsc = rsv[ai][m];
#pragma unroll
                    for (int bj = 0; bj < 2; ++bj) { const f32x4 v0 = acc[ai][bj][m][0] * rsc, v1 = acc[ai][bj][m][1] * rsc;
                        u32x4 w; w.x = cvt_pk_bf16(v0[0], v0[1]); w.y = cvt_pk_bf16(v0[2], v0[3]); w.z = cvt_pk_bf16(v1[0], v1[1]); w.w = cvt_pk_bf16(v1[2], v1[3]);
                        *(u32x4*)(rowp + bj * HALF) = w; } }
        } else {
            bf16_t* T = (u.pn < 8) ? Q : K; const int head = u.pn & 7; const int j0 = wc * 32 + 8 * fq;
#pragma unroll
            for (int ab = 0; ab < 4; ++ab) { const int ai = ab >> 1, mb = (ab & 1) * 2;
                f32x4 c0v[4], c1v[4], s0v[4], s1v[4]; float rsv[4];
#pragma unroll
                for (int m = mb; m < mb + 2; ++m) { const int row = row0 + ai * HALF + m * 16; int t = row_tpos(grow0 + row); t = t < 0 ? 0 : t;
                    c0v[m] = *(const f32x4*)(cosT + (size_t)t * 128 + j0); c1v[m] = *(const f32x4*)(cosT + (size_t)t * 128 + j0 + 4);
                    s0v[m] = *(const f32x4*)(sinT + (size_t)t * 128 + j0); s1v[m] = *(const f32x4*)(sinT + (size_t)t * 128 + j0 + 4); rsv[m] = rs[row]; }
#pragma unroll
                for (int m = mb; m < mb + 2; ++m) { const int row = row0 + ai * HALF + m * 16;
                    const f32x4 c0 = c0v[m], c1 = c1v[m], s0 = s0v[m], s1 = s1v[m];
                    const float rsc = rsv[m]; const f32x4 a0 = acc[ai][0][m][0] * rsc, a1 = acc[ai][0][m][1] * rsc, b0 = acc[ai][1][m][0] * rsc, b1 = acc[ai][1][m][1] * rsc;
                    const f32x4 x0 = a0 * c0 - b0 * s0, x1 = a1 * c1 - b1 * s1, y0 = a0 * s0 + b0 * c0, y1 = a1 * s1 + b1 * c1;
                    bf16_t* rowp = T + (size_t)row * 2048 + head * 256 + j0;
                    u32x4 w; w.x = cvt_pk_bf16(x0[0], x0[1]); w.y = cvt_pk_bf16(x0[2], x0[3]); w.z = cvt_pk_bf16(x1[0], x1[1]); w.w = cvt_pk_bf16(x1[2], x1[3]);
                    *(u32x4*)(rowp) = w;
                    w.x = cvt_pk_bf16(y0[0], y0[1]); w.y = cvt_pk_bf16(y0[2], y0[3]); w.z = cvt_pk_bf16(y1[0], y1[1]); w.w = cvt_pk_bf16(y1[2], y1[3]);
                    *(u32x4*)(rowp + 128) = w; } }
        }
    }
};
struct EpiMlaQ {
    static constexpr bool PERM = true, AFTER_DRAIN = false;
    bf16_t* Q; const float* cosT; const float* sinT; int grow0;
    __device__ __forceinline__ void operator()(const f32x4 (&acc)[2][2][4][2], const Unit& u, int wr, int wc, int fr, int fq) const {
        const int row0 = u.pm * BM + wr * 64 + fr; const int col0 = u.pn * BM + wc * 32 + 8 * fq;
#pragma unroll
        for (int ai = 0; ai < 2; ++ai) {
            f32x4 cv[4][2], sv[4][2];
#pragma unroll
            for (int m = 0; m < 4; ++m) { const int row = row0 + ai * HALF + m * 16; int t = row_tpos(grow0 + row); t = t < 0 ? 0 : t;
#pragma unroll
                for (int bj = 0; bj < 2; ++bj) { const int col = col0 + bj * HALF, w192 = col % 192; cv[m][bj] = (f32x4){1.f, 1.f, 1.f, 1.f}; sv[m][bj] = (f32x4){0.f, 0.f, 0.f, 0.f};
                    if (w192 >= 128) { const int jj = (w192 - 128) >> 1; cv[m][bj] = *(const f32x4*)(cosT + (size_t)t * 32 + jj); sv[m][bj] = *(const f32x4*)(sinT + (size_t)t * 32 + jj); } } }
#pragma unroll
            for (int m = 0; m < 4; ++m) { const int row = row0 + ai * HALF + m * 16;
#pragma unroll
                for (int bj = 0; bj < 2; ++bj) { f32x4 v0 = acc[ai][bj][m][0], v1 = acc[ai][bj][m][1];
                    const int col = col0 + bj * HALF, w192 = col % 192;
                    if (w192 >= 128) {
                        const f32x4 c = cv[m][bj], s = sv[m][bj];
                        const f32x4 r0 = {v0[0] * c[0] - v0[1] * s[0], v0[0] * s[0] + v0[1] * c[0], v0[2] * c[1] - v0[3] * s[1], v0[2] * s[1] + v0[3] * c[1]};
                        const f32x4 r1 = {v1[0] * c[2] - v1[1] * s[2], v1[0] * s[2] + v1[1] * c[2], v1[2] * c[3] - v1[3] * s[3], v1[2] * s[3] + v1[3] * c[3]};
                        v0 = r0; v1 = r1; }
                    u32x4 w; w.x = cvt_pk_bf16(v0[0], v0[1]); w.y = cvt_pk_bf16(v0[2], v0[3]); w.z = cvt_pk_bf16(v1[0], v1[1]); w.w = cvt_pk_bf16(v1[2], v1[3]);
                    *(u32x4*)(Q + (size_t)row * 3072 + col) = w; } } }
    }
};

template <class Epi, class Sched, bool ALIGN_EPI = false, bool SP2 = false>
__device__ __forceinline__ void gemm_phase(PG8_LAS unsigned char* lds, const Gemm g, const Sched& S, const Epi& E, const int tid_in) {
    const int tid = tid_in, wid = __builtin_amdgcn_readfirstlane(tid >> 6), lane = tid & 63, wr = wid >> 2, wc = wid & 3, fr = lane & 15, fq = lane >> 4;
    const int K = g.K, nt = K / BK;
    unsigned voffA[2], voffB[2];
#pragma unroll
    for (int i = 0; i < 2; ++i) { int R, C; stage_rc(tid * 16 + i * 8192, R, C); const int Rb = Epi::PERM ? ((R & ~31) + perm32(R & 31)) : R;
        voffA[i] = (unsigned)(R * g.lda + C) * 2u; voffB[i] = (unsigned)(Rb * g.ldb + C) * 2u; }
    const size_t kstep = (size_t)(BK * 2);
    const size_t hstepA = (size_t)HALF * g.lda * 2, hstepB = (size_t)HALF * g.ldb * 2;
    const size_t tstepA = 2 * hstepA, tstepB = 2 * hstepB;
    const unsigned ldsw = (unsigned)wid * 1024u;
    const int aoff = lds_byte(wr * 64 + fr, fq * 8), boff = lds_byte(wc * 32 + fr, fq * 8);
#define PG8_SA(b, h) (((b) * 2 + (h)) * HTB)
#define PG8_SB(b, h) ((4 + (b) * 2 + (h)) * HTB)
#define PG8_STAGE(bufoff, gbase, voff) do { _Pragma("unroll") for (int _i = 0; _i < 2; ++_i) \
        __builtin_amdgcn_global_load_lds((const unsigned*)((const char*)(gbase) + (voff)[_i]), (PG8_LAS unsigned*)(lds + (bufoff) + ldsw + _i * 8192), 16, 0, 0); } while (0)
#define PG8_LDA(dst, b, h) do { _Pragma("unroll") for (int m = 0; m < 4; ++m) _Pragma("unroll") for (int k = 0; k < 2; ++k) dst[m][k] = *(const PG8_LAS bf16x8*)(lds + PG8_SA(b, h) + aoff + m * 2048 + k * 1024); } while (0)
#define PG8_LDB(dst, b, h) do { _Pragma("unroll") for (int n = 0; n < 2; ++n) _Pragma("unroll") for (int k = 0; k < 2; ++k) dst[n][k] = *(const PG8_LAS bf16x8*)(lds + PG8_SB(b, h) + boff + n * 2048 + k * 1024); } while (0)
#define PG8_MMA(ai, bj, At, Bt) do { __builtin_amdgcn_s_setprio(1); _Pragma("unroll") for (int m = 0; m < 4; ++m) _Pragma("unroll") for (int n = 0; n < 2; ++n) _Pragma("unroll") for (int k = 0; k < 2; ++k) \
        acc[ai][bj][m][n] = __builtin_amdgcn_mfma_f32_16x16x32_bf16(Bt[n][k], At[m][k], acc[ai][bj][m][n], 0, 0, 0); __builtin_amdgcn_s_setprio(0); } while (0)
#define PG8_WAIT_V(n) asm volatile("s_waitcnt vmcnt(" #n ")" ::: "memory")
#define PG8_WAIT_L(n) asm volatile("s_waitcnt lgkmcnt(" #n ")" ::: "memory")
#define PG8_BAR __builtin_amdgcn_s_barrier()
#define PG8_SCHED __builtin_amdgcn_sched_barrier(0)
    Unit cur, nxt; int ui = 0;
    if (!S.next(0, cur)) return;
    f32x4 acc[2][2][4][2];
#pragma unroll
    for (int a = 0; a < 2; ++a)
#pragma unroll
        for (int b = 0; b < 2; ++b)
#pragma unroll
            for (int m = 0; m < 4; ++m)
#pragma unroll
                for (int n = 0; n < 2; ++n) acc[a][b][m][n] = (f32x4){0.f, 0.f, 0.f, 0.f};
    bf16x8 At[4][2], B0[2][2], B1[2][2];
    const char* cA = (const char*)g.A + (size_t)cur.pm * tstepA; const char* cB = (const char*)g.Bt + (size_t)cur.pn * tstepB;
    S.a_ready(cur);
    if constexpr (SP2) {
        PG8_STAGE(PG8_SB(0, 0), cB, voffB); PG8_STAGE(PG8_SB(0, 1), cB + hstepB, voffB); PG8_STAGE(PG8_SA(0, 0), cA, voffA); PG8_STAGE(PG8_SA(0, 1), cA + hstepA, voffA);
        if (wr == 1) PG8_BAR;
        PG8_WAIT_V(2); PG8_BAR;
        PG8_STAGE(PG8_SB(1, 0), cB + kstep, voffB); PG8_STAGE(PG8_SA(1, 0), cA + kstep, voffA); PG8_STAGE(PG8_SB(1, 1), cB + hstepB + kstep, voffB);
        PG8_WAIT_V(6); PG8_BAR;
    } else {
        PG8_STAGE(PG8_SB(0, 0), cB, voffB); PG8_STAGE(PG8_SA(0, 0), cA, voffA); PG8_STAGE(PG8_SB(0, 1), cB + hstepB, voffB); PG8_STAGE(PG8_SA(0, 1), cA + hstepA, voffA);
        if (wr == 1) PG8_BAR;
        PG8_WAIT_V(4); PG8_BAR;
        PG8_STAGE(PG8_SB(1, 0), cB + kstep, voffB); PG8_STAGE(PG8_SA(1, 0), cA + kstep, voffA); PG8_STAGE(PG8_SB(1, 1), cB + hstepB + kstep, voffB);
        PG8_WAIT_V(6); PG8_BAR;
    }
    for (;;) {
        const bool has_next = S.next(ui + 1, nxt);
        const char* nA = has_next ? (const char*)g.A + (size_t)nxt.pm * tstepA : cA; const char* nB = has_next ? (const char*)g.Bt + (size_t)nxt.pn * tstepB : cB;
        for (int t = 0; t < nt; t += 2) {
            const bool last = (t == nt - 2);
            const char* a1 = cA + (size_t)(t + 1) * kstep;
            const char* a2 = last ? nA : cA + (size_t)(t + 2) * kstep; const char* b2 = last ? nB : cB + (size_t)(t + 2) * kstep;
            const char* a3 = a2 + kstep; const char* b3 = b2 + kstep;
            if (last && has_next) S.a_ready(nxt);
            if constexpr (SP2) {
            PG8_LDB(B0, 0, 0); PG8_LDB(B1, 0, 1); PG8_SCHED; PG8_LDA(At, 0, 0); PG8_STAGE(PG8_SA(1, 1), a1 + hstepA, voffA);
            PG8_WAIT_V(8); PG8_WAIT_L(0); PG8_BAR; PG8_MMA(0, 0, At, B0); PG8_MMA(0, 1, At, B1); PG8_BAR; PG8_SCHED;
            PG8_LDA(At, 0, 1); PG8_STAGE(PG8_SB(0, 0), b2, voffB); PG8_STAGE(PG8_SB(0, 1), b2 + hstepB, voffB); PG8_STAGE(PG8_SA(0, 0), a2, voffA);
            PG8_WAIT_V(8); PG8_WAIT_L(0); PG8_BAR; PG8_MMA(1, 0, At, B0); PG8_MMA(1, 1, At, B1); PG8_BAR; PG8_SCHED;
            PG8_LDB(B0, 1, 0); PG8_LDB(B1, 1, 1); PG8_SCHED; PG8_LDA(At, 1, 0); PG8_STAGE(PG8_SA(0, 1), a2 + hstepA, voffA);
            PG8_WAIT_V(8); PG8_WAIT_L(0); PG8_BAR; PG8_MMA(0, 0, At, B0); PG8_MMA(0, 1, At, B1); PG8_BAR; PG8_SCHED;
            PG8_LDA(At, 1, 1); PG8_STAGE(PG8_SB(1, 0), b3, voffB); PG8_STAGE(PG8_SB(1, 1), b3 + hstepB, voffB); PG8_STAGE(PG8_SA(1, 0), a3, voffA);
            PG8_WAIT_V(8); PG8_WAIT_L(0); PG8_BAR; PG8_MMA(1, 0, At, B0); PG8_MMA(1, 1, At, B1); PG8_BAR; PG8_SCHED;
            } else {
            PG8_LDB(B0, 0, 0); PG8_SCHED; PG8_LDA(At, 0, 0); PG8_STAGE(PG8_SA(1, 1), a1 + hstepA, voffA);
            PG8_WAIT_L(8); PG8_BAR; PG8_WAIT_L(0); PG8_MMA(0, 0, At, B0); PG8_BAR; PG8_SCHED;
            PG8_LDB(B1, 0, 1); PG8_STAGE(PG8_SB(0, 0), b2, voffB);
            PG8_BAR; PG8_WAIT_L(0); PG8_MMA(0, 1, At, B1); PG8_BAR;
            PG8_LDA(At, 0, 1); PG8_STAGE(PG8_SA(0, 0), a2, voffA);
            PG8_BAR; PG8_WAIT_L(0); PG8_MMA(1, 0, At, B0); PG8_BAR; PG8_SCHED;
            PG8_STAGE(PG8_SB(0, 1), b2 + hstepB, voffB);
            PG8_WAIT_V(6); PG8_BAR; PG8_MMA(1, 1, At, B1); PG8_BAR;
            PG8_LDB(B0, 1, 0); PG8_SCHED; PG8_LDA(At, 1, 0); PG8_STAGE(PG8_SA(0, 1), a2 + hstepA, voffA);
            PG8_WAIT_L(8); PG8_BAR; PG8_WAIT_L(0); PG8_MMA(0, 0, At, B0); PG8_BAR; PG8_SCHED;
            PG8_LDB(B1, 1, 1); PG8_STAGE(PG8_SB(1, 0), b3, voffB);
            PG8_BAR; PG8_WAIT_L(0); PG8_MMA(0, 1, At, B1); PG8_BAR;
            PG8_LDA(At, 1, 1); PG8_STAGE(PG8_SA(1, 0), a3, voffA);
            PG8_BAR; PG8_WAIT_L(0); PG8_MMA(1, 0, At, B0); PG8_BAR; PG8_SCHED;
            PG8_STAGE(PG8_SB(1, 1), b3 + hstepB, voffB);
            PG8_WAIT_V(6); PG8_BAR; PG8_MMA(1, 1, At, B1); PG8_BAR;
            }
        }
        if constexpr (ALIGN_EPI) { if (wr == 0) PG8_BAR; }
        if constexpr (!Epi::AFTER_DRAIN) { E(acc, cur, wr, wc, fr, fq); S.done(cur); }
        if (!has_next) break;
#pragma unroll
        for (int a = 0; a < 2; ++a)
#pragma unroll
            for (int b = 0; b < 2; ++b)
#pragma unroll
                for (int m = 0; m < 4; ++m)
#pragma unroll
                    for (int n = 0; n < 2; ++n) acc[a][b][m][n] = (f32x4){0.f, 0.f, 0.f, 0.f};
        cur = nxt; cA = nA; cB = nB; ++ui;
        if constexpr (ALIGN_EPI) { if (wr == 1) PG8_BAR; }
    }
    PG8_WAIT_V(0);
    if constexpr (!ALIGN_EPI) { if (wr == 0) PG8_BAR; }
    PG8_BAR;
    if constexpr (Epi::AFTER_DRAIN) { E.fused(acc, cur, wr, wc, fr, fq, lds, wid, lane); S.done(cur); }
#undef PG8_SA
#undef PG8_SB
#undef PG8_STAGE
#undef PG8_LDA
#undef PG8_LDB
#undef PG8_MMA
#undef PG8_WAIT_V
#undef PG8_WAIT_L
#undef PG8_BAR
#undef PG8_SCHED
}
}

#define RLX_AGENT __ATOMIC_RELAXED, __HIP_MEMORY_SCOPE_AGENT
#define LDS_WAIT() asm volatile("s_waitcnt lgkmcnt(0)" ::: "memory")
#define VM_WAIT() asm volatile("s_waitcnt vmcnt(0)" ::: "memory")

#define XB_TMO      128
#define XB_XCNT(j)  (256  + 64 * (j))
#define XB_XSUB(j)  (1280 + 64 * (j))
#define XB_XGEN(j)  (2304 + 64 * (j))
#define XB_TOP      3328
#define XB_TOPGEN   3392
#define XCD_BAR_WORDS 3456
#define XB_SPIN_CAP (1u << 18)

__device__ __forceinline__ unsigned xb_ld(unsigned* p)              { return __hip_atomic_load(p, __ATOMIC_RELAXED, __HIP_MEMORY_SCOPE_AGENT); }
__device__ __forceinline__ unsigned xb_add(unsigned* p, unsigned v) { return __hip_atomic_fetch_add(p, v, __ATOMIC_RELAXED, __HIP_MEMORY_SCOPE_AGENT); }
__device__ __forceinline__ unsigned xb_xcc_id() { return (unsigned)__builtin_amdgcn_s_getreg((3 << 11) | 20) & 0xFu; }
#define XB_SPIN(cond, bar) do { unsigned _sp = 0; while (cond) { __builtin_amdgcn_s_sleep(1); \
    if ((++_sp & 255u) == 0u) { if (xb_ld(&(bar)[XB_TMO])) break; if (_sp > XB_SPIN_CAP) { atomicAdd(&(bar)[XB_TMO], 1u); break; } } } } while (0)

struct XcdBarrier {
    unsigned* bar; unsigned x;
    volatile LAS unsigned* st;
};

__device__ __forceinline__ XcdBarrier xcd_barrier_post(unsigned* bar, volatile LAS unsigned* st) {
    XcdBarrier b; b.bar = bar; b.x = xb_xcc_id(); b.st = st;
    if (threadIdx.x == 0) (void)xb_add(&bar[XB_XCNT(b.x)], 1u);
    return b;
}
__device__ __forceinline__ void xcd_barrier_complete(unsigned* bar, unsigned x, unsigned& nloc, unsigned& nx) {
    const unsigned G = gridDim.x * gridDim.y * gridDim.z;
    unsigned sum, cnt, mine, sp = 0u;
    for (;;) {
        sum = 0u; cnt = 0u; mine = 0u;
#pragma unroll
        for (unsigned j = 0; j < 16; ++j) { const unsigned c = xb_ld(&bar[XB_XCNT(j)]); sum += c; cnt += (c > 0u) ? 1u : 0u; mine = (j == x) ? c : mine; }
        if (sum == G) break;
        __builtin_amdgcn_s_sleep(1);
        if ((++sp & 255u) == 0u) { if (xb_ld(&bar[XB_TMO])) break; if (sp > XB_SPIN_CAP) { atomicAdd(&bar[XB_TMO], 1u); break; } }
    }
    nloc = mine > 0u ? mine : 1u; nx = cnt > 0u ? cnt : 1u;
}

__device__ __forceinline__ void xcd_barrier(const XcdBarrier& b, const bool is_t0  ) {
    asm volatile("s_waitcnt vmcnt(0)" ::: "memory");
    __syncthreads();
    if (is_t0) {
        unsigned* bar = b.bar;
        __builtin_amdgcn_s_waitcnt(0);
        unsigned nloc = b.st[0], nx = b.st[1];
        if (nloc == 0u) { xcd_barrier_complete(bar, b.x, nloc, nx); b.st[0] = nloc; b.st[1] = nx; }
        const unsigned old = xb_add(&bar[XB_XSUB(b.x)], 1u);
        const unsigned gen = old / nloc;
        if (old + 1u == (gen + 1u) * nloc) {
            __builtin_amdgcn_fence(__ATOMIC_RELEASE, "agent");
            asm volatile("s_waitcnt vmcnt(0)" ::: "memory");
            const unsigned og = xb_add(&bar[XB_TOP], 1u);
            const unsigned tg = og / nx;
            if (og + 1u == (tg + 1u) * nx) xb_add(&bar[XB_TOPGEN], 1u);
            else XB_SPIN(xb_ld(&bar[XB_TOPGEN]) == tg, bar);
            __builtin_amdgcn_fence(__ATOMIC_ACQUIRE, "agent");
            xb_add(&bar[XB_XGEN(b.x)], 1u);
            asm volatile("s_waitcnt vmcnt(0)" ::: "memory");
        } else {
            XB_SPIN(xb_ld(&bar[XB_XGEN(b.x)]) == gen, bar);
            __builtin_amdgcn_fence(__ATOMIC_ACQUIRE, "agent");
            asm volatile("s_waitcnt vmcnt(0)" ::: "memory");
        }
    }
    __syncthreads();
}

struct Args { const float* in[20]; float* out; unsigned char* ws; int ph_lo, ph_hi; float inv_ret[128]; float inv_mla[32]; float lg2[16]; };
static_assert(sizeof(Args) == 20 * 8 + 8 + 8 + 8 + (128 + 32 + 16) * 4, "Args has no padding");
struct Frame {
    LAS unsigned char* lds; char* ldsg;
    int tid, lane, wave, vcu, G, gw, NGW;
    int zero;
};
constexpr int AW_OUT = 40, AW_WS = 42, AW_INV_RET = 46, AW_INV_MLA = 46 + 128, AW_LG2 = 46 + 160;
__device__ __forceinline__ unsigned argw(const Frame& F, int w) { return ((const volatile LAS unsigned*)(F.lds + ARGS_OFF + F.zero))[w]; }
__device__ __forceinline__ float argf(const Frame& F, int w) { return __uint_as_float(argw(F, w)); }
__device__ __forceinline__ const float* arg_in(const Frame& F, int k) {
    const unsigned lo = __builtin_amdgcn_readfirstlane(argw(F, 2 * k)), hi = __builtin_amdgcn_readfirstlane(argw(F, 2 * k + 1));
    return (const float*)(const GAS float*)(((unsigned long long)hi << 32) | lo); }
__device__ __forceinline__ unsigned char* arg_ws(const Frame& F) { return (unsigned char*)arg_in(F, AW_WS / 2); }
__device__ __forceinline__ unsigned char* arg_out(const Frame& F) { return (unsigned char*)arg_in(F, AW_OUT / 2); }

__device__ __forceinline__ void sincos_d(double x, double& s, double& c) {
    const double TWO_PI = 6.283185307179586476925286766559, INV_2PI = 0.15915494309189533576888376337251;
    const double k = __builtin_rint(x * INV_2PI); double r = x - k * TWO_PI;
    const double y = r * 0.25, y2 = y * y;
    double sn = y * (1.0 - y2 / 6.0 * (1.0 - y2 / 20.0 * (1.0 - y2 / 42.0 * (1.0 - y2 / 72.0 * (1.0 - y2 / 110.0 * (1.0 - y2 / 156.0 * (1.0 - y2 / 210.0)))))));
    double cs = 1.0 - y2 / 2.0 * (1.0 - y2 / 12.0 * (1.0 - y2 / 30.0 * (1.0 - y2 / 56.0 * (1.0 - y2 / 90.0 * (1.0 - y2 / 132.0 * (1.0 - y2 / 182.0 * (1.0 - y2 / 240.0)))))));
    double s2 = 2.0 * sn * cs, c2 = 1.0 - 2.0 * sn * sn;
    s = 2.0 * s2 * c2; c = 1.0 - 2.0 * s2 * s2;
}
__device__ __forceinline__ void tables_phase(const Frame& F) {
    unsigned char* ws = arg_ws(F);
    float* cosR = (float*)(ws + TAB_COSR); float* sinR = (float*)(ws + TAB_SINR); float* cosM = (float*)(ws + TAB_COSM); float* sinM = (float*)(ws + TAB_SINM);
    const int gt = F.vcu * 512 + F.tid, NT = F.G * 512;
    for (int i = gt; i < LMAX * 160; i += NT) {
        const int t = i / 160, j = i % 160; double s, c;
        if (j < 128) { const float ang = (float)t * argf(F, AW_INV_RET + j); sincos_d((double)ang, s, c); cosR[t * 128 + j] = (float)c; sinR[t * 128 + j] = (float)s; }
        else { const int jm = j - 128; const float ang = (float)t * argf(F, AW_INV_MLA + jm); sincos_d((double)ang, s, c); cosM[t * 32 + jm] = (float)c; sinM[t * 32 + jm] = (float)s; }
    }
}

enum { MAP_ID = 0, MAP_KVB = 1, MAP_QB = 2, MAP_KVA = 3, MAP_ZERO = 4 };
__device__ __forceinline__ int map_col(int mode, int n) {
    if (mode == MAP_KVB) { const int hv = n >> 11, hh = (n & 2047) >> 7, i = n & 127; return hh * 256 + hv * 128 + i; }
    if (mode == MAP_QB)  { const int hh = n / 192, w = n % 192; if (w < 128) return n; const int p = w - 128, j = p >> 1; return hh * 192 + 128 + ((p & 1) ? 32 + j : j); }
    if (mode == MAP_KVA) { if (n < 512) return n; const int p = n - 512, j = p >> 1; return 512 + ((p & 1) ? 32 + j : j); }
    return n;
}
__device__ __forceinline__ void cvt_job(const Frame& F, const float* W, int K, int Nsrc, bf16_t* dst, int nrows, int mode, float scale, const float* gain = nullptr) {
    LAS float* scr = (LAS float*)(F.lds + F.wave * 16384);
    const int nblk = nrows / 32, nitems = (K / 64) * nblk, lane = F.lane;
    for (int it = F.gw; it < nitems; it += F.NGW) {
        const int kb = it / nblk, nb = it % nblk, k0 = 64 * kb, n0 = 32 * nb;
        const int nsrc = map_col(mode, n0 + (lane & 31));
#pragma unroll 8
        for (int i = 0; i < 32; ++i) { const int kk = 2 * i + (lane >> 5); scr[kk * 33 + (lane & 31)] = (mode == MAP_ZERO) ? 0.f : W[(size_t)(k0 + kk) * Nsrc + nsrc] * (gain ? scale * gain[k0 + kk] : scale); }
        LDS_WAIT(); asm volatile("" ::: "memory");
        const int c = lane & 7;
#pragma unroll
        for (int j = 0; j < 4; ++j) { const int n = (lane >> 3) + 8 * j; const LAS float* s = scr + (8 * c) * 33 + n;
            u32x4 o; o.x = cvt_pk_bf16(s[0 * 33], s[1 * 33]); o.y = cvt_pk_bf16(s[2 * 33], s[3 * 33]); o.z = cvt_pk_bf16(s[4 * 33], s[5 * 33]); o.w = cvt_pk_bf16(s[6 * 33], s[7 * 33]);
            *(GAS u32x4*)(dst + (size_t)(n0 + n) * K + k0 + 8 * c) = o; }
        LDS_WAIT(); asm volatile("" ::: "memory");
    }
}
__device__ __forceinline__ void convert_phase(const Frame& F, int L, int part) {
    unsigned char* wr = arg_ws(F) + WS_W; const int j = L >> 1;
    const float* g1 = arg_in(F, 3) + (size_t)L * D;
    if (part != 2) {
    if ((L & 1) == 0) {
        bf16_t* qkv = (bf16_t*)(wr + W_RQKV);
        cvt_job(F, arg_in(F, 7) + (size_t)j * D * 2048, D, 2048, qkv, 2048, MAP_ID, 1.f, g1);
        cvt_job(F, arg_in(F, 8) + (size_t)j * D * 2048, D, 2048, qkv + (size_t)2048 * D, 2048, MAP_ID, 0.0625f, g1);
        cvt_job(F, arg_in(F, 9) + (size_t)j * D * 4096, D, 4096, qkv + (size_t)4096 * D, 4096, MAP_ID, 1.f, g1);
        cvt_job(F, arg_in(F, 10) + (size_t)j * D * 4096, D, 4096, (bf16_t*)(wr + W_RG), 4096, MAP_ID, 1.f, g1);
        cvt_job(F, arg_in(F, 11) + (size_t)j * 4096 * D, 4096, D, (bf16_t*)(wr + W_RO), D, MAP_ID, 1.f);
    } else {
        bf16_t* wa = (bf16_t*)(wr + W_MA);
        cvt_job(F, arg_in(F, 12) + (size_t)j * D * 512, D, 512, wa, 512, MAP_ID, 1.f, g1);
        cvt_job(F, arg_in(F, 15) + (size_t)j * D * 576, D, 576, wa + (size_t)512 * D, 576, MAP_KVA, 1.f, g1);
        cvt_job(F, arg_in(F, 12), D, 512, wa + (size_t)1088 * D, MA_N - 1088, MAP_ZERO, 0.f);
        cvt_job(F, arg_in(F, 14) + (size_t)j * 512 * 3072, 512, 3072, (bf16_t*)(wr + W_MQB), 3072, MAP_QB, 0.10411584120765913f);
        cvt_job(F, arg_in(F, 17) + (size_t)j * 512 * 4096, 512, 4096, (bf16_t*)(wr + W_MKVB), 4096, MAP_KVB, 1.f);
        cvt_job(F, arg_in(F, 18) + (size_t)j * D * D, D, D, (bf16_t*)(wr + W_MO), D, MAP_ID, 1.f);
    }
    cvt_job(F, arg_in(F, 5) + (size_t)L * D * FF, D, FF, (bf16_t*)(wr + W_1), FF, MAP_ID, 1.f);
    }
    if (part != 1) cvt_job(F, arg_in(F, 6) + (size_t)L * FF * D, FF, D, (bf16_t*)(wr + W_2), D, MAP_ID, 1.f);
}

__device__ __forceinline__ void embed_phase(const Frame& F) {
    unsigned char* ws = arg_ws(F); bf16_t* H = (bf16_t*)(ws + WS_H); float* RS = (float*)(ws + WS_RSTD);
    const float* xm = arg_in(F, 2); const float* xp = arg_in(F, 0); const float* xs = arg_in(F, 1);
    for (int r = F.gw; r < MT; r += F.NGW) {
        const int seq = r < ROWS0 ? r / LP_P : NP + (r - ROWS0) / LP_S; const int t = row_tpos(r);
        GAS u32x2* hp = (GAS u32x2*)(H + (size_t)r * D) + F.lane;
        if (t < 0) {
#pragma unroll
            for (int j = 0; j < 8; ++j) hp[64 * j] = (u32x2){0u, 0u};
            if (F.lane == 0) RS[r] = 0.f;
            continue; }
        const float* src = t < NMETA ? xm + (size_t)t * D : (seq < NP ? xp + ((size_t)seq * SP + (t - NMETA)) * D : xs + ((size_t)(seq - NP) * SS + (t - NMETA)) * D);
        float ss = 0.f;
#pragma unroll
        for (int j = 0; j < 8; ++j) { const f32x4 v = __builtin_nontemporal_load((const GAS f32x4*)src + F.lane + 64 * j);
            const unsigned w0 = cvt_pk_bf16(v[0], v[1]), w1 = cvt_pk_bf16(v[2], v[3]); hp[64 * j] = (u32x2){w0, w1};
            const float a0 = bf_lo(w0), a1 = bf_hi(w0), a2 = bf_lo(w1), a3 = bf_hi(w1); ss += (a0 * a0 + a1 * a1) + (a2 * a2 + a3 * a3); }
        const float rstd = 1.0f / sqrtf(wave_sum(ss) * (1.f / D) + NORM_EPS);
        if (F.lane == 0) RS[r] = rstd;
    }
}
__device__ __forceinline__ void rowstat_phase(const Frame& F) {
    unsigned char* ws = arg_ws(F); const bf16_t* H = (const bf16_t*)(ws + WS_H); float* RS = (float*)(ws + WS_RSTD);
    for (int r0 = F.gw; r0 < MT; r0 += 4 * F.NGW) {
        u32x4 w[4][4];
#pragma unroll
        for (int k = 0; k < 4; ++k) { const int r = r0 + k * F.NGW; if (r < MT) { const GAS u32x4* hp = (const GAS u32x4*)(H + (size_t)r * D) + F.lane;
#pragma unroll
            for (int j = 0; j < 4; ++j) w[k][j] = hp[64 * j]; } }
#pragma unroll
        for (int k = 0; k < 4; ++k) { const int r = r0 + k * F.NGW; if (r < MT) { float ss = 0.f;
#pragma unroll
            for (int j = 0; j < 4; ++j)
#pragma unroll
                for (int e = 0; e < 4; ++e) { const float x = bf_lo(w[k][j][e]), y = bf_hi(w[k][j][e]); ss += x * x + y * y; }
            const float rstd = 1.0f / sqrtf(wave_sum(ss) * (1.f / D) + NORM_EPS);
            if (F.lane == 0) RS[r] = rstd; } }
    }
}
__device__ __forceinline__ void rowstat_fin_phase(const Frame& F) {
    float* RS = (float*)(arg_ws(F) + WS_RSTD); const float* P = (const float*)((const unsigned char*)arg_out(F) + O_PART);
    for (int r = F.gw * 64 + F.lane; r < MT; r += F.NGW * 64) { const GAS f32x4* p = (const GAS f32x4*)(P + (size_t)r * 32); float sacc = 0.f;
#pragma unroll
        for (int j = 0; j < 8; ++j) { const f32x4 v = p[j]; sacc += (v[0] + v[1]) + (v[2] + v[3]); }
        RS[r] = 1.0f / sqrtf(sacc * (1.f / D) + NORM_EPS); }
}
__device__ __forceinline__ void norm_phase(const Frame& F, const float* g) {
    unsigned char* ws = arg_ws(F); const bf16_t* H = (const bf16_t*)(ws + WS_H); bf16_t* A = (bf16_t*)(ws + WS_A);
    for (int r0 = F.gw; r0 < MT; r0 += 2 * F.NGW) {
        u32x4 w[2][4];
#pragma unroll
        for (int k = 0; k < 2; ++k) { const int r = r0 + k * F.NGW; if (r < MT) { const GAS u32x4* hp = (const GAS u32x4*)(H + (size_t)r * D) + F.lane;
#pragma unroll
            for (int j = 0; j < 4; ++j) w[k][j] = hp[64 * j]; } }
#pragma unroll
        for (int k = 0; k < 2; ++k) { const int r = r0 + k * F.NGW; if (r < MT) { GAS u32x4* ap = (GAS u32x4*)(A + (size_t)r * D) + F.lane; float ss = 0.f;
#pragma unroll
            for (int j = 0; j < 4; ++j)
#pragma unroll
                for (int e = 0; e < 4; ++e) { const float x = bf_lo(w[k][j][e]), y = bf_hi(w[k][j][e]); ss += x * x + y * y; }
            const float rstd = 1.0f / sqrtf(wave_sum(ss) * (1.f / D) + NORM_EPS);
#pragma unroll
            for (int j = 0; j < 4; ++j) { const f32x4 g0 = *((const GAS f32x4*)g + 2 * (F.lane + 64 * j)), g1 = *((const GAS f32x4*)g + 2 * (F.lane + 64 * j) + 1); u32x4 o;
                o.x = cvt_pk_bf16(bf_lo(w[k][j].x) * rstd * g0[0], bf_hi(w[k][j].x) * rstd * g0[1]); o.y = cvt_pk_bf16(bf_lo(w[k][j].y) * rstd * g0[2], bf_hi(w[k][j].y) * rstd * g0[3]);
                o.z = cvt_pk_bf16(bf_lo(w[k][j].z) * rstd * g1[0], bf_hi(w[k][j].z) * rstd * g1[1]); o.w = cvt_pk_bf16(bf_lo(w[k][j].w) * rstd * g1[2], bf_hi(w[k][j].w) * rstd * g1[3]);
                ap[64 * j] = o; } } }
    }
}
__device__ __forceinline__ void final_phase(const Frame& F) {
    const bf16_t* H = (const bf16_t*)(arg_ws(F) + WS_H); const float* g = arg_in(F, 19); float* outp = (float*)arg_out(F);
    constexpr int NREAL = NP * SP + NS * SS;
    for (int i = F.gw; i < NREAL; i += F.NGW) {
        int r; if (i < NP * SP) r = (i / SP) * LP_P + PADF + NMETA + (i % SP); else { const int k = i - NP * SP; r = ROWS0 + (k / SS) * LP_S + PADF + NMETA + (k % SS); }
        const GAS u32x4* hp = (const GAS u32x4*)(H + (size_t)r * D) + F.lane; GAS f32x4* op = (GAS f32x4*)(outp + (size_t)i * D);
        u32x4 w[4]; float ss = 0.f;
#pragma unroll
        for (int j = 0; j < 4; ++j) { w[j] = __builtin_nontemporal_load(hp + 64 * j);
#pragma unroll
            for (int e = 0; e < 4; ++e) { const float x = bf_lo(w[j][e]), y = bf_hi(w[j][e]); ss += x * x + y * y; } }
        const float rstd = 1.0f / sqrtf(wave_sum(ss) * (1.f / D) + NORM_EPS);
#pragma unroll
        for (int j = 0; j < 4; ++j) { const int c2 = 2 * (F.lane + 64 * j); const f32x4 g0 = *((const GAS f32x4*)g + c2), g1 = *((const GAS f32x4*)g + c2 + 1);
            __builtin_nontemporal_store((f32x4){bf_lo(w[j].x) * rstd * g0[0], bf_hi(w[j].x) * rstd * g0[1], bf_lo(w[j].y) * rstd * g0[2], bf_hi(w[j].y) * rstd * g0[3]}, op + c2);
            __builtin_nontemporal_store((f32x4){bf_lo(w[j].z) * rstd * g1[0], bf_hi(w[j].z) * rstd * g1[1], bf_lo(w[j].w) * rstd * g1[2], bf_hi(w[j].w) * rstd * g1[3]}, op + c2 + 1); }
    }
}

__device__ __forceinline__ void ret_combine_phase(const Frame& F, const bf16_t* OF, const bf16_t* OB, const bf16_t* Gt, bf16_t* U, int rows) {
    const int nitems = rows * RH;
    for (int it0 = F.gw; it0 < nitems; it0 += 4 * F.NGW) {
        u32x4 a[4], b[4], g[4];
#pragma unroll
        for (int k = 0; k < 4; ++k) { const int it = it0 + k * F.NGW; if (it < nitems) { const size_t off = (size_t)it * 512 + F.lane * 8;
            a[k] = __builtin_nontemporal_load((const GAS u32x4*)(OF + off)); b[k] = __builtin_nontemporal_load((const GAS u32x4*)(OB + off)); g[k] = __builtin_nontemporal_load((const GAS u32x4*)(Gt + off)); } }
#pragma unroll
        for (int k = 0; k < 4; ++k) { const int it = it0 + k * F.NGW; if (it < nitems) { const size_t off = (size_t)it * 512 + F.lane * 8;
            float o[8]; float s = 0.f;
#pragma unroll
            for (int e = 0; e < 4; ++e) { o[2 * e] = bf_lo(a[k][e]) + bf_lo(b[k][e]); o[2 * e + 1] = bf_hi(a[k][e]) + bf_hi(b[k][e]); s += o[2 * e] + o[2 * e + 1]; }
            const float mu = wave_sum(s) * (1.f / 512.f); float q = 0.f;
#pragma unroll
            for (int e = 0; e < 8; ++e) { o[e] -= mu; q += o[e] * o[e]; }
            const float rstd = 1.0f / sqrtf(wave_sum(q) * (1.f / 512.f) + NORM_EPS);
            u32x4 w;
#pragma unroll
            for (int e = 0; e < 4; ++e) { const float g0 = bf_lo(g[k][e]), g1 = bf_hi(g[k][e]);
                const float y0 = o[2 * e] * rstd, y1 = o[2 * e + 1] * rstd;
                const float s0 = g0 / (1.f + __expf(-g0)), s1 = g1 / (1.f + __expf(-g1));
                w[e] = cvt_pk_bf16(s0 * y0, s1 * y1); }
            *(GAS u32x4*)(U + off) = w; } }
    }
}

__device__ __forceinline__ void mla_rowpass_phase(const Frame& F, int j, const bf16_t* CQKV, bf16_t* CN, bf16_t* KR, int rows, int grow0) {
    const float* gq = arg_in(F, 13) + (size_t)j * 512; const float* gkv = arg_in(F, 16) + (size_t)j * 512; unsigned char* ws = arg_ws(F);
    const float* cosM = (const float*)(ws + TAB_COSM); const float* sinM = (const float*)(ws + TAB_SINM);
    for (int r = F.gw; r < rows; r += F.NGW) {
        const bf16_t* src = CQKV + (size_t)r * MA_N;
        const u32x4 wq = *(const GAS u32x4*)(src + F.lane * 8), wk = *(const GAS u32x4*)(src + 512 + F.lane * 8);
        float q[8], k[8]; float sq = 0.f, sk = 0.f;
#pragma unroll
        for (int e = 0; e < 4; ++e) { q[2 * e] = bf_lo(wq[e]); q[2 * e + 1] = bf_hi(wq[e]); k[2 * e] = bf_lo(wk[e]); k[2 * e + 1] = bf_hi(wk[e]);
            sq += q[2 * e] * q[2 * e] + q[2 * e + 1] * q[2 * e + 1]; sk += k[2 * e] * k[2 * e] + k[2 * e + 1] * k[2 * e + 1]; }
        const float rq = 1.0f / sqrtf(wave_sum(sq) * (1.f / 512.f) + NORM_EPS), rk = 1.0f / sqrtf(wave_sum(sk) * (1.f / 512.f) + NORM_EPS);
        const f32x4 gq0 = *((const GAS f32x4*)gq + 2 * F.lane), gq1 = *((const GAS f32x4*)gq + 2 * F.lane + 1), gk0 = *((const GAS f32x4*)gkv + 2 * F.lane), gk1 = *((const GAS f32x4*)gkv + 2 * F.lane + 1);
        u32x4 oq, ok;
        oq.x = cvt_pk_bf16(q[0] * rq * gq0[0], q[1] * rq * gq0[1]); oq.y = cvt_pk_bf16(q[2] * rq * gq0[2], q[3] * rq * gq0[3]); oq.z = cvt_pk_bf16(q[4] * rq * gq1[0], q[5] * rq * gq1[1]); oq.w = cvt_pk_bf16(q[6] * rq * gq1[2], q[7] * rq * gq1[3]);
        ok.x = cvt_pk_bf16(k[0] * rk * gk0[0], k[1] * rk * gk0[1]); ok.y = cvt_pk_bf16(k[2] * rk * gk0[2], k[3] * rk * gk0[3]); ok.z = cvt_pk_bf16(k[4] * rk * gk1[0], k[5] * rk * gk1[1]); ok.w = cvt_pk_bf16(k[6] * rk * gk1[2], k[7] * rk * gk1[3]);
        *(GAS u32x4*)(CN + (size_t)r * 1024 + F.lane * 8) = oq; *(GAS u32x4*)(CN + (size_t)r * 1024 + 512 + F.lane * 8) = ok;
        if (F.lane < 32) {
            const unsigned w = *(const GAS unsigned*)(src + 1024 + 2 * F.lane); int t = row_tpos(grow0 + r); t = t < 0 ? 0 : t;
            const float x1 = bf_lo(w), x2 = bf_hi(w), c = cosM[(size_t)t * 32 + F.lane], s = sinM[(size_t)t * 32 + F.lane];
            *(GAS unsigned*)(KR + (size_t)r * 64 + 2 * F.lane) = cvt_pk_bf16(x1 * c - x2 * s, x1 * s + x2 * c);
        }
    }
}

namespace rscan {
constexpr int RS = 272;
constexpr int L_Q = 0, L_K = 128 * RS, L_V = 2 * 128 * RS, L_P = 3 * 128 * RS, L_END = 4 * 128 * RS;
static_assert(L_END <= ARGS_OFF, "scan LDS");
typedef short v4i16_t __attribute__((ext_vector_type(4)));
__device__ __forceinline__ s16x4 tr_read(LAS unsigned char* p) { return __builtin_bit_cast(s16x4, __builtin_amdgcn_ds_read_tr16_b64_v4i16((LAS v4i16_t*)p)); }
__device__ __forceinline__ bf16x8 pack8(s16x4 lo, s16x4 hi) { return (bf16x8){lo[0], lo[1], lo[2], lo[3], hi[0], hi[1], hi[2], hi[3]}; }

constexpr int PS = 528;
__device__ __forceinline__ void pmat_phase(const Frame& F, const bf16_t* Q, const bf16_t* K, bf16_t* PB, int half) {
    const int nseq = half ? NS : NP, nchunk = half ? LP_S / 128 : LP_P / 128;
    const int nunits = nseq * nchunk * RH;
    const int tid = F.tid, lane = tid & 63, wv = tid >> 6, l15 = lane & 15, quad = lane >> 4;
    LAS unsigned char* const lg = F.lds;
    LAS unsigned char* const bQown = lg + (16 * wv + l15) * PS + 16 * quad;
    LAS unsigned char* const bK    = lg + 128 * PS + l15 * PS + 16 * quad;
    const int srow = tid >> 5, scc = tid & 31;
    for (int u = F.vcu; u < nunits; u += F.G) {
        const int head = u & 7, sc = u >> 3;
        const float lgf = __uint_as_float(__builtin_amdgcn_readfirstlane(argw(F, AW_LG2 + head))), lgb = __uint_as_float(__builtin_amdgcn_readfirstlane(argw(F, AW_LG2 + 8 + head)));
        const size_t u0 = (size_t)sc * 128 * 2048 + head * 256; const unsigned lq = (unsigned)(srow * 2048 + scc * 8);
#pragma unroll
        for (int ii = 0; ii < 8; ++ii) { const u32x4 qv = *(const GAS u32x4*)(Q + u0 + (size_t)ii * 16 * 2048 + lq), kv = *(const GAS u32x4*)(K + u0 + (size_t)ii * 16 * 2048 + lq);
            *(LAS u32x4*)(lg + (srow + 16 * ii) * PS + scc * 16) = qv; *(LAS u32x4*)(lg + 128 * PS + (srow + 16 * ii) * PS + scc * 16) = kv; }
        __syncthreads();
        bf16x8 Qf[8];
#pragma unroll
        for (int ks = 0; ks < 8; ++ks) Qf[ks] = *(const LAS bf16x8*)(bQown + 64 * ks);
        bf16_t* pout = PB + (size_t)u * 16384; const unsigned lpo = (unsigned)((16 * wv + l15) * 128 + 4 * quad); const int i_abs = 16 * wv + l15;
#pragma unroll
        for (int jt = 0; jt < 8; ++jt) { f32x4 st = {0.f, 0.f, 0.f, 0.f};
#pragma unroll
            for (int ks = 0; ks < 8; ++ks) { const bf16x8 Kf = *(const LAS bf16x8*)(bK + 16 * jt * PS + 64 * ks); st = __builtin_amdgcn_mfma_f32_16x16x32_bf16(Kf, Qf[ks], st, 0, 0, 0); }
#pragma unroll
            for (int r = 0; r < 4; ++r) { const int jj = 16 * jt + 4 * quad + r;
                st[r] *= __builtin_amdgcn_exp2f(jj <= i_abs ? lgf * (float)(-jj - 1) : lgb * (float)(jj - 128)); }
            *(GAS u32x2*)(pout + 16 * jt + lpo) = (u32x2){cvt_pk_bf16(st[0], st[1]), cvt_pk_bf16(st[2], st[3])}; }
        __syncthreads();
    }
}

__device__ __forceinline__ void glds16s(const void* gsrc, unsigned lds_dst) { unsigned keep;
    asm volatile("s_mov_b32 %0, m0\n\ts_mov_b32 m0, %2\n\ts_nop 0\n\tglobal_load_lds_dwordx4 %1, off\n\ts_mov_b32 m0, %0" : "=&s"(keep) : "v"(gsrc), "s"(lds_dst) : "memory"); }
__device__ __forceinline__ void glds16u(const void* sbase, unsigned voff, unsigned lds_dst) { unsigned keep;
    asm volatile("s_mov_b32 %0, m0\n\ts_mov_b32 m0, %3\n\ts_nop 0\n\tglobal_load_lds_dwordx4 %1, %2\n\ts_mov_b32 m0, %0" : "=&s"(keep) : "v"(voff), "s"(sbase), "s"(lds_dst) : "memory"); }
#define SCAN_BAR() asm volatile("s_waitcnt lgkmcnt(0)\n\ts_barrier" ::: "memory")
__device__ __forceinline__ int qk_swz(int r) { return ((r >> 1) & 1) | ((((r >> 1) ^ (r >> 2)) & 1) << 1) | (((r >> 3) & 1) << 2); }
constexpr int QS = 128, S_QK = 128 * QS  , LQ0 = 0, LQ1 = S_QK, LK0 = 2 * S_QK, LK1 = 3 * S_QK, LV2 = 4 * S_QK  , LP2 = LV2 + 32768, L_END2 = LP2 + 32768;
static_assert(L_END2 <= ARGS_OFF, "scan LDS");
constexpr int pv_pair(int dir, int n) { int c = 0; for (int it = 0; it < 8; ++it) for (int ks = 0; ks < 4; ++ks) { const int dks = ks - (it >> 1); if (dir ? dks >= 0 : dks <= 0) { if (c == n) return it * 4 + ks; ++c; } } return -1; }
template <int M, int N, class Fn> __device__ __forceinline__ void mattn_sfor(Fn&& f) { if constexpr (M < N) { f(std::integral_constant<int, M>{}); mattn_sfor<M + 1, N>(f); } }
__device__ __forceinline__ void scan_phase(const Frame& F, const bf16_t* Q, const bf16_t* K, const bf16_t* V, const bf16_t* PB, bf16_t* OF, bf16_t* OB, int half) {
    const int nseq = half ? NS : NP, nchunk = half ? LP_S / 128 : LP_P / 128, Lp = nchunk * 128;
    const int nunits = nseq * RH * 2 * 4;
    const int tid = F.tid, lane = tid & 63, wv = tid >> 6  , l15 = lane & 15, quad = lane >> 4;
    LAS unsigned char* const lg = F.lds;
    LAS unsigned char* bQs[2][2];
#pragma unroll
    for (int ks = 0; ks < 2; ++ks)
#pragma unroll
        for (int sec = 0; sec < 2; ++sec) bQs[ks][sec] = lg + l15 * QS + (((4 * ks + 2 * sec + (quad >> 1)) ^ qk_swz(l15)) << 4) + 8 * (quad & 1);
    LAS unsigned char* bKlo[4]; LAS unsigned char* bKhi[4];
#pragma unroll
    for (int mt = 0; mt < 4; ++mt) { const int kr = 8 * quad + (l15 >> 2), kc = 2 * mt + ((l15 & 3) >> 1);
        bKlo[mt] = lg + kr * QS + ((kc ^ qk_swz(kr)) << 4) + 8 * (l15 & 1); bKhi[mt] = lg + (kr + 4) * QS + ((kc ^ qk_swz(kr + 4)) << 4) + 8 * (l15 & 1); }
    const int vx = 8 * (quad & 1) + (l15 >> 2), vch = 2 * wv + ((l15 & 3) >> 1);
    LAS unsigned char* const bVlo  = lg + LV2 + (8 * quad + (l15 >> 2)) * 256 + ((vch ^ vx) << 4) + 8 * (l15 & 1);
    LAS unsigned char* const bVhi  = lg + LV2 + (8 * quad + (l15 >> 2) + 4) * 256 + ((vch ^ vx ^ 4) << 4) + 8 * (l15 & 1);
    LAS unsigned char* bPk[4];
#pragma unroll
    for (int ks = 0; ks < 4; ++ks) bPk[ks] = lg + LP2 + l15 * 256 + ((((4 * ks + quad) ^ l15) & 15) << 4);
    const int drow0 = 16 * wv + (lane >> 4); unsigned dc8[4];
#pragma unroll
    for (int n = 0; n < 4; ++n) dc8[n] = (unsigned)((((lane & 15) ^ ((drow0 + 4 * n) & 15))) * 8);
    const unsigned ldsV = (unsigned)(uintptr_t)F.ldsg + LV2 + F.wave * 4096, ldsP = (unsigned)(uintptr_t)F.ldsg + LP2 + F.wave * 4096;
    const int srow = tid >> 3, scc = tid & 7;
    LAS unsigned char* const bSt = lg + srow * QS + ((scc ^ qk_swz(srow)) << 4);
    const unsigned lqk = (unsigned)(srow * 2048 + scc * 8);
    for (int u = blockIdx.x; u < nunits; u += F.G) {
        const int x = u & 7, loc = u >> 3, vq = loc & 3, grp = (loc >> 2) * 8 + x;
        const int dirr = grp & 1, head = (grp >> 1) & 7, seq = grp >> 4;
        const float lg2 = __uint_as_float(__builtin_amdgcn_readfirstlane(argw(F, AW_LG2 + dirr * 8 + head)));
        const float c1 = __builtin_amdgcn_exp2f(128.f * lg2);
        const size_t rb = (size_t)seq * Lp;
        bf16_t* O = dirr ? OB : OF;
        auto unit_body = [&](auto dir_c) { constexpr int dir = decltype(dir_c)::value;
        int drow0_l = drow0; unsigned dc8_l[4] = {dc8[0], dc8[1], dc8[2], dc8[3]}; asm volatile("" : "+v"(drow0_l), "+v"(dc8_l[0]), "+v"(dc8_l[1]), "+v"(dc8_l[2]), "+v"(dc8_l[3]));
        const float gm1 = __uint_as_float(__builtin_amdgcn_readfirstlane(__float_as_uint(__builtin_amdgcn_exp2f(dir ? lg2 : -lg2)))), gm32 = __uint_as_float(__builtin_amdgcn_readfirstlane(__float_as_uint(__builtin_amdgcn_exp2f((dir ? 32.f : -32.f) * lg2)))),
                    gm16 = __uint_as_float(__builtin_amdgcn_readfirstlane(__float_as_uint(__builtin_amdgcn_exp2f((dir ? -16.f : 16.f) * lg2))));
        unsigned lqk_l = lqk; asm volatile("" : "+v"(lqk_l));
        f32x4 Rt[16];
#pragma unroll
        for (int i = 0; i < 16; ++i) Rt[i] = (f32x4){0.f, 0.f, 0.f, 0.f};
        u32x4 rq[2], rk[2];
#define SCAN_LOAD_QK(cc, pq) do { const size_t u0_ = (rb + (size_t)(cc) * 128) * 2048 + head * 256 + (pq) * 64;     \
            _Pragma("unroll") for (int ii = 0; ii < 2; ++ii) { rq[ii] = *(const GAS u32x4*)(Q + u0_ + (size_t)ii * 64 * 2048 + lqk_l); rk[ii] = *(const GAS u32x4*)(K + u0_ + (size_t)ii * 64 * 2048 + lqk_l); } } while (0)
#define SCAN_WRITE_QK(par) do { _Pragma("unroll") for (int ii = 0; ii < 2; ++ii) { *(LAS u32x4*)(bSt + ((par) ? LQ1 : LQ0) + ii * 64 * QS) = rq[ii]; *(LAS u32x4*)(bSt + ((par) ? LK1 : LK0) + ii * 64 * QS) = rk[ii]; } } while (0)
#define SCAN_DMA_VP(cc) do { const bf16_t* vs_ = V + (rb + (size_t)(cc) * 128) * 4096 + head * 512 + vq * 128; const bf16_t* ps_ = PB + ((size_t)(seq * nchunk + (cc)) * RH + head) * 16384; \
            _Pragma("unroll") for (int n_ = 0; n_ < 4; ++n_) { glds16u(vs_, ((unsigned)(drow0_l + 4 * n_) * 4096u + dc8_l[n_]) * 2u, ldsV + n_ * 1024); glds16u(ps_, ((unsigned)(drow0_l + 4 * n_) * 128u + dc8_l[n_]) * 2u, ldsP + n_ * 1024); } } while (0)
        unsigned pmk[2][4];
#pragma unroll
        for (int par = 0; par < 2; ++par) { int nk = 16 * par + l15 - 8 * quad + 1; nk = nk < 0 ? 0 : (nk > 8 ? 8 : nk);
#pragma unroll
            for (int d_ = 0; d_ < 4; ++d_) { const unsigned mf = ((2 * d_ < nk) ? 0xffffu : 0u) | ((2 * d_ + 1 < nk) ? 0xffff0000u : 0u); pmk[par][d_] = dir ? ~mf : mf; } }
        { const int c0 = dir ? nchunk - 1 : 0; SCAN_DMA_VP(c0); SCAN_LOAD_QK(c0, 0); SCAN_WRITE_QK(0); SCAN_LOAD_QK(c0, 1); }
        SCAN_BAR();
        for (int s = 0; s < nchunk; ++s) {
            const int c = dir ? nchunk - 1 - s : s, cn = dir ? nchunk - 2 - s : s + 1; const size_t r0 = rb + (size_t)c * 128; const bool more = s + 1 < nchunk;
            f32x4 Ot[8]; bf16x8 Vf[4];
#pragma unroll
            for (int i = 0; i < 8; ++i) Ot[i] = (f32x4){0.f, 0.f, 0.f, 0.f};
            int quad_l = quad, l15_l = l15; asm volatile("" : "+v"(quad_l), "+v"(l15_l));
#pragma unroll
            for (int p = 0; p < 4; ++p) {
                if (p < 3 || more) SCAN_WRITE_QK((p + 1) & 1);
                if (p == 1 && more) SCAN_DMA_VP(cn);
                if (p < 2) SCAN_LOAD_QK(c, p + 2); else if (more) SCAN_LOAD_QK(cn, p - 2);
                if (p == 0) {
#pragma unroll
                    for (int ks = 0; ks < 4; ++ks) { const s16x4 lo = tr_read(bVlo + 32 * ks * 256), hi = tr_read(bVhi + 32 * ks * 256); Vf[ks] = pack8(lo, hi); }
                    __builtin_amdgcn_sched_barrier(0);
                    { u32x4 pwb[2];
                      { constexpr int q0_ = pv_pair(dir, 0); pwb[0] = *(const LAS u32x4*)(bPk[q0_ & 3] + 16 * (q0_ >> 2) * 256); }
                      __builtin_amdgcn_sched_group_barrier(0x100, 1, 0);
                      mattn_sfor<0, 20>([&](auto n_) { constexpr int n = decltype(n_)::value, pr = pv_pair(dir, n), it = pr >> 2, ks = pr & 3, dks = ks - (it >> 1);
                          if constexpr (n + 1 < 20) { constexpr int nx = pv_pair(dir, n + 1); pwb[(n + 1) & 1] = *(const LAS u32x4*)(bPk[nx & 3] + 16 * (nx >> 2) * 256); }
                          u32x4 pw = pwb[n & 1];
                          if constexpr (dks == 0) { pw.x &= pmk[it & 1][0]; pw.y &= pmk[it & 1][1]; pw.z &= pmk[it & 1][2]; pw.w &= pmk[it & 1][3]; }
                          Ot[it] = __builtin_amdgcn_mfma_f32_16x16x32_bf16(Vf[ks], __builtin_bit_cast(bf16x8, pw), Ot[it], 0, 0, 0);
                          __builtin_amdgcn_sched_group_barrier(0x100, 1, 0); __builtin_amdgcn_sched_group_barrier(0x8, 1, 0); }); }
                    __builtin_amdgcn_sched_barrier(0);
                    { float fk = __builtin_amdgcn_exp2f(lg2 * (float)(dir ? 8 * quad_l : 127 - 8 * quad_l));
#pragma unroll
                      for (int ks = 0; ks < 4; ++ks) { u32x4 vw = __builtin_bit_cast(u32x4, Vf[ks]); float f = fk;
#pragma unroll
                        for (int e2 = 0; e2 < 4; ++e2) { const float f0 = f, f1 = f * gm1; f = f1 * gm1;
                            vw[e2] = cvt_pk_bf16(bf_lo(vw[e2]) * f0, bf_hi(vw[e2]) * f1); }
                        Vf[ks] = __builtin_bit_cast(bf16x8, vw); fk *= gm32; } }
                }
                __builtin_amdgcn_sched_barrier(0);
                {
                    bf16x8 Rf[2];
#pragma unroll
                    for (int ks = 0; ks < 2; ++ks) { const f32x4 r0v = Rt[4 * p + 2 * ks], r1v = Rt[4 * p + 2 * ks + 1];
                        const u32x4 wvv = {cvt_pk_bf16(r0v[0], r0v[1]), cvt_pk_bf16(r0v[2], r0v[3]), cvt_pk_bf16(r1v[0], r1v[1]), cvt_pk_bf16(r1v[2], r1v[3])};
                        Rf[ks] = __builtin_bit_cast(bf16x8, wvv); }
                    u32x4 qf[2][2];
#define SCAN_QREAD(b_, it_) do { _Pragma("unroll") for (int ks = 0; ks < 2; ++ks) { const int qo = ((p & 1) ? LQ1 : LQ0) + 16 * (it_) * QS; \
                        const u32x2 lo = *(const volatile LAS u32x2*)(bQs[ks][0] + qo), hi = *(const volatile LAS u32x2*)(bQs[ks][1] + qo);     qf[b_][ks] = (u32x4){lo.x, lo.y, hi.x, hi.y}; } } while (0)
                    SCAN_QREAD(0, 0);
#pragma unroll
                    for (int it = 0; it < 8; ++it) { if (it < 7) SCAN_QREAD((it + 1) & 1, it + 1);
#pragma unroll
                        for (int ks = 0; ks < 2; ++ks) Ot[it] = __builtin_amdgcn_mfma_f32_16x16x32_bf16(Rf[ks], __builtin_bit_cast(bf16x8, qf[it & 1][ks]), Ot[it], 0, 0, 0); }
#undef SCAN_QREAD
                    __builtin_amdgcn_sched_group_barrier(0x100, 4, 0);
                    __builtin_amdgcn_sched_group_barrier(0x100, 4, 0); __builtin_amdgcn_sched_group_barrier(0x8, 2, 0);
                    __builtin_amdgcn_sched_group_barrier(0x100, 4, 0); __builtin_amdgcn_sched_group_barrier(0x8, 2, 0);
                    __builtin_amdgcn_sched_group_barrier(0x100, 4, 0); __builtin_amdgcn_sched_group_barrier(0x8, 2, 0);
                    __builtin_amdgcn_sched_group_barrier(0x100, 4, 0); __builtin_amdgcn_sched_group_barrier(0x8, 2, 0);
                    __builtin_amdgcn_sched_group_barrier(0x100, 4, 0); __builtin_amdgcn_sched_group_barrier(0x8, 2, 0);
                    __builtin_amdgcn_sched_group_barrier(0x100, 4, 0); __builtin_amdgcn_sched_group_barrier(0x8, 2, 0);
                    __builtin_amdgcn_sched_group_barrier(0x100, 4, 0); __builtin_amdgcn_sched_group_barrier(0x8, 2, 0);
                    __builtin_amdgcn_sched_group_barrier(0x8, 2, 0);
                }
                __builtin_amdgcn_sched_barrier(0);
                { s16x4 kl[2][4], kh[2][4];
#define SCAN_KREAD(b_, mt_) do { _Pragma("unroll") for (int ks = 0; ks < 4; ++ks) { const int ko = ((p & 1) ? LK1 : LK0) + 32 * ks * QS; kl[b_][ks] = tr_read(bKlo[mt_] + ko); kh[b_][ks] = tr_read(bKhi[mt_] + ko); } } while (0)
                SCAN_KREAD(0, 0);
#pragma unroll
                for (int mt = 0; mt < 4; ++mt) { if (mt < 3) SCAN_KREAD((mt + 1) & 1, mt + 1);
                    f32x4 acc = Rt[4 * p + mt] * c1;
#pragma unroll
                    for (int ks = 0; ks < 4; ++ks) acc = __builtin_amdgcn_mfma_f32_16x16x32_bf16(pack8(kl[mt & 1][ks], kh[mt & 1][ks]), Vf[ks], acc, 0, 0, 0);
                    Rt[4 * p + mt] = acc; }
#undef SCAN_KREAD
                __builtin_amdgcn_sched_group_barrier(0x100, 8, 0);
                __builtin_amdgcn_sched_group_barrier(0x100, 8, 0); __builtin_amdgcn_sched_group_barrier(0x8, 4, 0);
                __builtin_amdgcn_sched_group_barrier(0x100, 8, 0); __builtin_amdgcn_sched_group_barrier(0x8, 4, 0);
                __builtin_amdgcn_sched_group_barrier(0x100, 8, 0); __builtin_amdgcn_sched_group_barrier(0x8, 4, 0);
                __builtin_amdgcn_sched_group_barrier(0x8, 4, 0);
                }
                if (p == 3) {
                    bf16_t* ob_ = O + r0 * 4096 + head * 512 + vq * 128; const unsigned lo_ = (unsigned)(l15_l * 4096 + 16 * wv + 4 * quad);
                    float fi = __builtin_amdgcn_exp2f(lg2 * (float)(dir ? 128 - l15_l : l15_l + 1));
#pragma unroll
                    for (int it = 0; it < 8; ++it) {
                        *(GAS u32x2*)(ob_ + (size_t)(16 * it) * 4096 + lo_) = (u32x2){cvt_pk_bf16(Ot[it][0] * fi, Ot[it][1] * fi), cvt_pk_bf16(Ot[it][2] * fi, Ot[it][3] * fi)}; fi *= gm16; }
                }
                SCAN_BAR();
            }
        }
        };
        if (dirr) unit_body(std::integral_constant<int, 1>{}); else unit_body(std::integral_constant<int, 0>{});
#undef SCAN_LOAD_QK
#undef SCAN_DMA_VP
#undef SCAN_WRITE_QK
    }
}
}

namespace mattn {
constexpr int NW = 8, QBLK = 32, KVBLK = 64;
constexpr int SHM_V = KVBLK * MV * 2  , SHM_K = KVBLK * MQK * 2  , SHM_QR = 2 * SHM_V + 2 * SHM_K + NW * 64 * 4  , NQL = 0  , SHM_ATTN = SHM_QR + NW * NQL * 1024;
static_assert(SHM_ATTN <= ARGS_OFF, "attention LDS");
constexpr float THR2 = 11.0f;
#define KSWZ(row, colB) ((row) * 384 + ((colB) ^ (((row) & 7) << 4)))
#define SBAR() __builtin_amdgcn_sched_barrier(0)
#define PIN2(A, B) asm volatile("" : "+v"(A), "+v"(B))
__device__ __forceinline__ int crow(int r, int hi) { return (r & 3) + 8 * (r >> 2) + 4 * hi; }
typedef __bf16 bf16x2_n __attribute__((ext_vector_type(2)));
typedef float f32x2_n __attribute__((ext_vector_type(2)));
__device__ __forceinline__ unsigned cvt_pk_n(float lo, float hi) { f32x2_n v = {lo, hi}; return __builtin_bit_cast(unsigned, __builtin_convertvector(v, bf16x2_n)); }
__device__ __forceinline__ bf16x8 pk_swz(unsigned a0, unsigned a1, unsigned b0, unsigned b1) {
    auto r0 = __builtin_amdgcn_permlane32_swap(a0, b0, false, false); auto r1 = __builtin_amdgcn_permlane32_swap(a1, b1, false, false);
    u32x4 w = {r0[0], r1[0], r0[1], r1[1]}; return __builtin_bit_cast(bf16x8, w); }
template <int M, int N, class Fn> __device__ __forceinline__ void sfor(Fn&& f) { if constexpr (M < N) { f(std::integral_constant<int, M>{}); sfor<M + 1, N>(f); } }
struct PsmSt { float c0, c1, mn; };
template <int N> __device__ __forceinline__ void psm_slice(f32x16& p0, f32x16& p1, float& m_reg, float& alpha, PsmSt& st) {
    if constexpr (N == 0) { float c = fmaxf(p0[0], p0[1]);
#pragma unroll
        for (int r = 2; r < 16; r += 2) c = fmaxf(fmaxf(c, p0[r]), p0[r + 1]);
        st.c0 = c; }
    else if constexpr (N == 1) { float c = fmaxf(p1[0], p1[1]);
#pragma unroll
        for (int r = 2; r < 16; r += 2) c = fmaxf(fmaxf(c, p1[r]), p1[r + 1]);
        st.c1 = c; }
    else if constexpr (N == 2) { float pmax = fmaxf(st.c0, st.c1);
        auto rr = __builtin_amdgcn_permlane32_swap(__float_as_uint(pmax), __float_as_uint(pmax), false, false); pmax = fmaxf(__uint_as_float(rr[0]), __uint_as_float(rr[1]));
        const bool keep = __all(pmax - m_reg <= THR2);
        st.mn = keep ? m_reg : fmaxf(m_reg, pmax); }
    else if constexpr (N == 3) { alpha = __builtin_amdgcn_exp2f(m_reg - st.mn); m_reg = st.mn; }
    else if constexpr (N < 8) { constexpr int r = 2 * (N - 4); p0[r] = __builtin_amdgcn_exp2f(p0[r] - st.mn); p0[r + 1] = __builtin_amdgcn_exp2f(p0[r + 1] - st.mn); }
    else { constexpr int r = N; p0[r] = __builtin_amdgcn_exp2f(p0[r] - st.mn); }
}
struct FinSt { float s0, s1; unsigned c[16]; };
template <int M> __device__ __forceinline__ void fin_slice(f32x16& p0, f32x16& p1, float mreg, float alpha, float& l_reg, FinSt& st, bf16x8 (&pa)[4]) {
    if constexpr (M < 16) {
        p1[M] = __builtin_amdgcn_exp2f(p1[M] - mreg);
        if constexpr (M == 0) st.s0 = p0[0]; else st.s0 += p0[M];
        if constexpr ((M & 1) == 0) st.c[M / 2] = cvt_pk_n(p0[M], p0[M + 1]);
    } else if constexpr (M < 20) {
        constexpr int k = M - 16;
        if constexpr (k == 0) st.s1 = p1[0]; else st.s1 += p1[4 * k];
        st.s1 += p1[4 * k + 1]; st.s1 += p1[4 * k + 2]; st.s1 += p1[4 * k + 3];
        st.c[8 + 2 * k] = cvt_pk_n(p1[4 * k], p1[4 * k + 1]); st.c[9 + 2 * k] = cvt_pk_n(p1[4 * k + 2], p1[4 * k + 3]);
        if constexpr (k == 0) pa[0] = pk_swz(st.c[0], st.c[1], st.c[2], st.c[3]);
        if constexpr (k == 1) pa[1] = pk_swz(st.c[4], st.c[5], st.c[6], st.c[7]);
    } else if constexpr (M == 20) pa[2] = pk_swz(st.c[8], st.c[9], st.c[10], st.c[11]);
    else if constexpr (M == 21) pa[3] = pk_swz(st.c[12], st.c[13], st.c[14], st.c[15]);
    else if constexpr (M == 22) { float ps = st.s0 + st.s1;
        auto rr = __builtin_amdgcn_permlane32_swap(__float_as_uint(ps), __float_as_uint(ps), false, false); ps = __uint_as_float(rr[0]) + __uint_as_float(rr[1]);
        l_reg = l_reg * alpha + ps; }
}
__device__ __forceinline__ int v_st(int k, int c) { const int kk = (k & ~0xC) | ((k & 4) << 1) | ((k & 8) >> 1); return ((kk >> 3) * 4 + (c >> 5)) * 512 + ((kk & 7) * 32 + (c & 31)) * 2; }
__device__ __forceinline__ int v_rd_base(int lane) { return ((lane & 3) << 3) | (((lane >> 2) & 3) << 6) | (((lane >> 4) & 1) << 5) | (((lane >> 5) & 1) << 8); }
constexpr int v_rd_off(int d0, int ks, int half) { return d0 * 512 + ks * 4096 + half * 2048; }
template <int OFF> __device__ __forceinline__ s16x4 tr_read(int vb) { return __builtin_amdgcn_ds_read_tr16_b64_v4i16((LAS s16x4*)(unsigned)(vb + OFF)); }
template <bool FIN, bool PRE, int DM, class Dma> __device__ __forceinline__ void region_qk(f32x16& ps0, f32x16& ps1, const char* Ks, const bf16x8* qr, const char* qslot, const int (&kb)[4],
                                                              f32x16& pf0, f32x16& pf1, float mreg, float alpha, float& l_reg, bf16x8 (&pa)[4], int vb, s16x4 (&l)[4], s16x4 (&h)[4], Dma&& dma) {
    bf16x8 kf[2][2], qf[2]; FinSt st;
#define QKT_RD(d_, B) do { const char* kp_ = Ks + kb[(d_) & 3] + ((d_) >> 2) * 128; kf[B][0] = *reinterpret_cast<const bf16x8*>(kp_); kf[B][1] = *reinterpret_cast<const bf16x8*>(kp_ + 32 * 384); \
        if constexpr ((d_) < 12 - NQL) qf[B] = qr[(d_) < 12 - NQL ? (d_) : 0]; else qf[B] = *reinterpret_cast<const bf16x8*>(qslot + ((d_) - (12 - NQL)) * 1024); } while (0)
    QKT_RD(0, 0);
    sfor<0, 12>([&](auto d_) { constexpr int d0 = decltype(d_)::value, cb = d0 & 1, nb = cb ^ 1;
        if constexpr (d0 < 11) QKT_RD(d0 + 1, nb);
        if constexpr (d0 == 0) ps0 = __builtin_amdgcn_mfma_f32_32x32x16_bf16(kf[cb][0], qf[cb], f32x16{}, 0, 0, 0);
        else ps0 = __builtin_amdgcn_mfma_f32_32x32x16_bf16(kf[cb][0], qf[cb], ps0, 0, 0, 0);
        if constexpr (FIN) fin_slice<2 * d0>(pf0, pf1, mreg, alpha, l_reg, st, pa);
        if constexpr (PRE && d0 >= 10) { constexpr int k = 2 * (d0 - 10); l[k] = tr_read<v_rd_off(0, k, 0)>(vb); h[k] = tr_read<v_rd_off(0, k, 1)>(vb); }
        __builtin_amdgcn_sched_group_barrier(0x100, 3, 0); __builtin_amdgcn_sched_group_barrier(0x8, 1, 0);
        SBAR();
        if constexpr (d0 == 0) ps1 = __builtin_amdgcn_mfma_f32_32x32x16_bf16(kf[cb][1], qf[cb], f32x16{}, 0, 0, 0);
        else ps1 = __builtin_amdgcn_mfma_f32_32x32x16_bf16(kf[cb][1], qf[cb], ps1, 0, 0, 0);
        if constexpr (FIN) fin_slice<2 * d0 + 1>(pf0, pf1, mreg, alpha, l_reg, st, pa);
        if constexpr (PRE && d0 >= 10) { constexpr int k = 2 * (d0 - 10) + 1; l[k] = tr_read<v_rd_off(0, k, 0)>(vb); h[k] = tr_read<v_rd_off(0, k, 1)>(vb); }
        if constexpr ((d0 & 1) == 0 && d0 < 10 && (DM == 1 || (DM == 2 && d0 >= 6))) dma(std::integral_constant<int, d0 / 2>{});
        __builtin_amdgcn_sched_group_barrier(0x8, 1, 0);
        SBAR();
    });
#undef QKT_RD
}
template <bool PSM, bool PRE> __device__ __forceinline__ void region_pv(f32x16* o, int vb, const bf16x8 (&pa)[4], f32x16& pn0, f32x16& pn1, float& m_reg, float& alpha, s16x4 (&l)[4], s16x4 (&h)[4]) {
    PsmSt st;
    if constexpr (!PRE) {
    l[0] = tr_read<v_rd_off(0, 0, 0)>(vb); h[0] = tr_read<v_rd_off(0, 0, 1)>(vb); l[1] = tr_read<v_rd_off(0, 1, 0)>(vb); h[1] = tr_read<v_rd_off(0, 1, 1)>(vb);
    l[2] = tr_read<v_rd_off(0, 2, 0)>(vb); h[2] = tr_read<v_rd_off(0, 2, 1)>(vb); l[3] = tr_read<v_rd_off(0, 3, 0)>(vb); h[3] = tr_read<v_rd_off(0, 3, 1)>(vb);
    SBAR(); }
    sfor<0, 16>([&](auto n_) { constexpr int n = decltype(n_)::value, b = n >> 2, k = n & 3;
        o[b] = __builtin_amdgcn_mfma_f32_32x32x16_bf16(pa[k], (bf16x8){l[k][0], l[k][1], l[k][2], l[k][3], h[k][0], h[k][1], h[k][2], h[k][3]}, o[b], 0, 0, 0);
        if constexpr (b < 3) { l[k] = tr_read<v_rd_off((b + 1) & 3, k, 0)>(vb); h[k] = tr_read<v_rd_off((b + 1) & 3, k, 1)>(vb); }
        if constexpr (PSM) psm_slice<n>(pn0, pn1, m_reg, alpha, st);
        __builtin_amdgcn_sched_group_barrier(0x8, 1, 0); __builtin_amdgcn_sched_group_barrier(0x100, 2, 0);
        SBAR();
    });
}
__device__ __forceinline__ void finishSM(f32x16& p0, f32x16& p1, float mreg, float alpha, float& l_reg, bf16x8 (&pa)[4]) { FinSt st; sfor<0, 23>([&](auto m_) { fin_slice<decltype(m_)::value>(p0, p1, mreg, alpha, l_reg, st, pa); }); }
__device__ __forceinline__ void mask_48(f32x16& p0, f32x16& p1) {
#pragma unroll
    for (int r = 0; r < 16; ++r) p0[r] = -INFINITY;
#pragma unroll
    for (int r = 0; r < 8; ++r) p1[r] = -INFINITY;
}
__device__ __forceinline__ void glds16(const void* gsrc, unsigned lds_dst) { unsigned keep;
    asm volatile("s_mov_b32 %0, m0\n\ts_mov_b32 m0, %2\n\ts_nop 0\n\tglobal_load_lds_dwordx4 %1, off\n\ts_mov_b32 m0, %0" : "=&s"(keep) : "v"(gsrc), "s"(lds_dst) : "memory"); }
#define WAITV(N) asm volatile("s_waitcnt vmcnt(" #N ")" ::: "memory")
#define LBAR() asm volatile("s_waitcnt lgkmcnt(0)\n\ts_barrier" ::: "memory")
__device__ __forceinline__ void attn_unit(const bf16_t* __restrict__ Qs, const bf16_t* __restrict__ Kn, const bf16_t* __restrict__ Kr, const bf16_t* __restrict__ Vs, bf16_t* Os, int q0, int Lp, char* lds, const int tid) {
    const int wid = tid >> 6, lane = tid & 63, r32 = lane & 31, hi = lane >> 5; const int wu = __builtin_amdgcn_readfirstlane(wid);
    char* V_lds = lds; char* K_lds = lds + 2 * SHM_V;
    float* ws = (float*)(lds + 2 * SHM_V + 2 * SHM_K) + wid * 64; float* li_l = ws; float* al_l = ws + 32;
    float m_reg = -1e30f, l_reg = 0; f32x16 o[4] = {}; bf16x8 qr[12 - NQL];
    char* qslot = lds + SHM_QR + wid * (NQL * 1024) + lane * 16;
    int kb[4];
#pragma unroll
    for (int c = 0; c < 4; ++c) kb[c] = KSWZ(r32, c * 32 + hi * 16);
    const bf16_t* ksrc[3];
#pragma unroll
    for (int n = 0; n < 3; ++n) { const int p = (wid * 3 + n) * 64 + lane, row = p / 24, cp = p % 24, c = (cp & 24) | ((cp ^ row) & 7);
        ksrc[n] = c < 16 ? Kn + (size_t)row * 2048 + c * 8 : Kr + (size_t)row * 64 + (c - 16) * 8; }
    unsigned vsrc[2];
#pragma unroll
    for (int n = 0; n < 2; ++n) { const int p = (wid * 2 + n) * 64 + lane, sub = p >> 5, elt = (p & 31) * 8, kk = (sub >> 2) * 8 + (elt >> 5), k = (kk & ~0xC) | ((kk & 4) << 1) | ((kk & 8) >> 1), c = (sub & 3) * 32 + (elt & 31);
        vsrc[n] = (unsigned)(k * 2048 + c) * 2u; }
    const unsigned lK = (unsigned)(uintptr_t)K_lds + wu * 3072, lV = (unsigned)(uintptr_t)V_lds + wu * 2048;
    bool krope[3];
#pragma unroll
    for (int n = 0; n < 3; ++n) { const int p = (wid * 3 + n) * 64 + lane, row = p / 24, cp = p % 24, c = (cp & 24) | ((cp ^ row) & 7); krope[n] = c >= 16; }
#define DMA_K(t, b) do { _Pragma("unroll") for (int n_ = 0; n_ < 3; ++n_) glds16(ksrc[n_] + (size_t)(t) * (krope[n_] ? KVBLK * 64 : KVBLK * 2048), lK + (b) * SHM_K + n_ * 1024); } while (0)
#define DMA_V(t, b) do { const bf16_t* vt_ = Vs + (size_t)(t) * KVBLK * 2048; _Pragma("unroll") for (int n_ = 0; n_ < 2; ++n_) rscan::glds16u(vt_, vsrc[n_], lV + (b) * SHM_V + n_ * 1024); } while (0)
    DMA_K(1, 1); DMA_V(0, 0);
    const bf16_t* Qw = Qs + (size_t)(q0 + wid * QBLK + r32) * 3072 + hi * 8;
#pragma unroll
    for (int d0 = 0; d0 < 12 - NQL; ++d0) qr[d0] = *reinterpret_cast<const bf16x8*>(Qw + d0 * 16);
#pragma unroll
    for (int d0 = 12 - NQL; d0 < 12; ++d0) *reinterpret_cast<bf16x8*>(qslot + (d0 - (12 - NQL)) * 1024) = *reinterpret_cast<const bf16x8*>(Qw + d0 * 16);
    const int vb0 = (int)(uintptr_t)V_lds + v_rd_base(lane);
#define RESC(a) do { if (__any((a) < 1.f)) { if (hi == 0) al_l[r32] = (a); asm volatile("s_waitcnt lgkmcnt(0)" ::: "memory"); \
    _Pragma("unroll") for (int d = 0; d < 4; ++d) _Pragma("unroll") for (int r = 0; r < 16; ++r) o[d][r] *= al_l[crow(r, hi)]; } } while (0)
    f32x16 pA0, pA1, pB0, pB1; float alA = 1.f, alB; bf16x8 pa[4]; s16x4 vl[4], vh[4]; const int NT = Lp / KVBLK;
    static_assert(PADF >= KVBLK && PADF < 2 * KVBLK, "tile 0 fully masked, tile 1 partly");
#define DMA_FN(KT, KB, VT, VBUF) [&](auto pc_) { constexpr int pc = decltype(pc_)::value; \
        if constexpr (pc < 3) glds16(ksrc[pc] + (size_t)(KT) * (krope[pc] ? KVBLK * 64 : KVBLK * 2048), lK + (KB) * SHM_K + pc * 1024); \
        else rscan::glds16u(Vs + (size_t)(VT) * KVBLK * 2048, vsrc[pc - 3], lV + (VBUF) * SHM_V + (pc - 3) * 1024); }
    pA0 = f32x16{};
#pragma unroll
    for (int r = 0; r < 16; ++r) pA1[r] = -INFINITY;
    WAITV(0); LBAR();
    for (int j = 1; j + 1 < NT; j += 2) {
        SBAR(); region_qk<true, true, 1>(pB0, pB1, K_lds + SHM_K, qr, qslot, kb, pA0, pA1, m_reg, alA, l_reg, pa, vb0, vl, vh, DMA_FN(j + 1, 0, j, 1));
        if (j == 1) { asm volatile("" ::: "memory"); mask_48(pB0, pB1); }
        region_pv<true, true>(o, vb0, pa, pB0, pB1, m_reg, alB, vl, vh); PIN2(pB0, pB1);
        RESC(alB);
        WAITV(0); LBAR();
        SBAR(); region_qk<true, true, 1>(pA0, pA1, K_lds, qr, qslot, kb, pB0, pB1, m_reg, alB, l_reg, pa, vb0 + SHM_V, vl, vh, DMA_FN(j + 2, 1, j + 1, 0));
        region_pv<true, true>(o, vb0 + SHM_V, pa, pA0, pA1, m_reg, alA, vl, vh); PIN2(pA0, pA1);
        RESC(alA);
        WAITV(0); LBAR();
    }
    SBAR(); region_qk<true, true, 2>(pB0, pB1, K_lds + SHM_K, qr, qslot, kb, pA0, pA1, m_reg, alA, l_reg, pa, vb0, vl, vh, DMA_FN(0, 0, NT - 1, 1));
    region_pv<true, true>(o, vb0, pa, pB0, pB1, m_reg, alB, vl, vh); PIN2(pB0, pB1);
    RESC(alB);
    WAITV(0); LBAR();
    finishSM(pB0, pB1, m_reg, alB, l_reg, pa); SBAR();
    region_pv<false, false>(o, vb0 + SHM_V, pa, pB0, pB1, m_reg, alB, vl, vh);
#undef DMA_FN
    if (hi == 0) li_l[r32] = l_reg; asm volatile("s_waitcnt lgkmcnt(0)" ::: "memory");
    float rli[16];
#pragma unroll
    for (int r = 0; r < 16; ++r) rli[r] = __builtin_amdgcn_rcpf(li_l[crow(r, hi)]);
#pragma unroll
    for (int r = 0; r < 16; ++r) { const int rs = q0 + wid * QBLK + crow(r, hi);
        if (rs < Lp) { const float keep = rs >= PADF ? rli[r] : 0.f; bf16_t* orow = Os + (size_t)rs * 2048;
#pragma unroll
            for (int d0 = 0; d0 < 4; ++d0) orow[d0 * 32 + r32] = (bf16_t)(cvt_pk_bf16(o[d0][r] * keep, 0.f) & 0xffffu); } }
    LBAR();
#undef DMA_K
#undef DMA_V
#undef RESC
}
__device__ __forceinline__ void attn_phase(const Frame& F, const bf16_t* Q, const bf16_t* KN, const bf16_t* KR, const bf16_t* V, bf16_t* O) {
    constexpr int NQP = (LP_P + 255) / 256, NQS = (LP_S + 255) / 256, NUP = NP * MH * NQP  , NUS = NS * MH * NQS  ;
    const int c = F.vcu; const bool exact = (F.G == 256);
    const int np = exact ? (c < 64 ? 9 : 8) : (NUP - c + F.G - 1) / F.G, ns = exact ? (c < 64 ? 7 : 9) : 0;
    const int ntot = exact ? np + ns : (NUP + NUS - c + F.G - 1) / F.G;
    for (int i = 0; i < ntot; ++i) {
        int u; bool smp;
        if (exact) { smp = i >= np; u = !smp ? (i < 8 ? c + 256 * i : 2048 + c) : (c < 64 ? c + 64 * (i - np) : 448 + (c - 64) + 192 * (i - np)); }
        else { const int g = c + F.G * i; smp = g >= NUP; u = smp ? g - NUP : g; }
        const int nqb = smp ? NQS : NQP, Lp = smp ? LP_S : LP_P;
        const int qb = u % nqb, sh = u / nqb, head = sh % MH, seq = sh / MH; const size_t rb = (smp ? (size_t)ROWS0 : 0) + (size_t)seq * Lp;
        attn_unit(Q + rb * 3072 + head * MQK, KN + rb * 2048 + head * MNOPE, KR + rb * 64, V + rb * 2048 + head * MV, O + rb * 2048 + head * MV, qb * 256, Lp, F.ldsg, F.tid);
    }
}
#undef KSWZ
#undef SBAR
}

__device__ __forceinline__ int hw_lane() { unsigned m_ = ~0u; asm volatile("" : "+s"(m_)); return (int)__builtin_amdgcn_mbcnt_hi(m_, __builtin_amdgcn_mbcnt_lo(m_, 0u)); }
constexpr int NWAVES = 8;
constexpr int N_PHASES = 2 * (1 + 11 + 1 + 3) + 2 * (1 + 5 + 1 + 3) + 1;
__global__ void __launch_bounds__(NWAVES * 64, 2) mk_fwd(Args args) {
    extern __shared__ __attribute__((aligned(16))) unsigned char lds[];
    Frame F;
    F.lds = (LAS unsigned char*)lds; F.ldsg = (char*)lds;
    F.tid = threadIdx.x; F.lane = F.tid & 63; F.wave = __builtin_amdgcn_readfirstlane(F.tid >> 6); const int wave0 = F.wave;
    F.G = gridDim.x; { const int bx = blockIdx.x; F.vcu = (F.G % 8 == 0) ? (bx % 8) * (F.G / 8) + bx / 8 : bx; }
    F.gw = F.vcu * NWAVES + F.wave; F.NGW = F.G * NWAVES; { int z_ = 0; asm volatile("" : "+v"(z_)); F.zero = z_; }
    volatile LAS unsigned* MISC = (volatile LAS unsigned*)(F.lds + MISC_OFF);
    if (F.tid < 64) MISC[F.tid] = 0u;
    { const __attribute__((address_space(4))) unsigned* kp = (const __attribute__((address_space(4))) unsigned*)__builtin_amdgcn_kernarg_segment_ptr();
      if (F.tid < (int)(sizeof(Args) / 4)) ((LAS unsigned*)(F.lds + ARGS_OFF))[F.tid] = kp[F.tid]; }
    __syncthreads();
    const int lo = args.ph_lo, hi = args.ph_hi;
    XcdBarrier bar = xcd_barrier_post((unsigned*)(arg_ws(F) + WS_CTL) + 4096, MISC + 8);
    int ph = 0;
#define PH_ON (ph >= lo && ph < hi)
#define HW_TID() (wave0 * 64 + hw_lane())
#define PH_END do { if (ph >= lo && ph + 1 < hi) xcd_barrier(bar, HW_TID() == 0); ++ph; } while (0)
#define FRESH() Frame Fp = F; { int t_ = HW_TID(); asm volatile("" : "+v"(t_)); Fp.tid = t_; Fp.lane = t_ & 63; Fp.wave = __builtin_amdgcn_readfirstlane(t_ >> 6); int v_ = F.vcu; asm volatile("" : "+s"(v_)); Fp.vcu = v_; Fp.gw = v_ * NWAVES + Fp.wave; int z_ = 0; asm volatile("" : "+v"(z_)); Fp.zero = z_; }
#define WSP(off) (arg_ws(F) + (off))
#define OBP(off) (arg_out(Fp) + (off))

    for (int L = 0; L < DEPTH; ++L) {
        if (PH_ON && EN_PREP) { FRESH();
            if (L == 0) { tables_phase(Fp); embed_phase(Fp); }
            else rowstat_fin_phase(Fp);
            convert_phase(Fp, L, (L == 0 || F.G != 256) ? 0 : 2);
        }
        PH_END;
        if ((L & 1) == 0) {
            for (int half = 0; half < 2; ++half) {
                const int row0 = half ? ROWS0 : 0, rows = half ? ROWS1 : ROWS0;
                if (PH_ON && EN_G1) { FRESH();
                    unsigned char* ws = arg_ws(Fp);
                    pg8::Gemm g{(const bf16_t*)(ws + WS_H) + (size_t)row0 * D, (const bf16_t*)(ws + WS_W + W_RQKV), rows, 8192, D, D, D}; pg8::StaticOrder S; S.init(rows, 8192, F.G, (int)blockIdx.x);
                    pg8::EpiRetQKV E{(bf16_t*)OBP(O_RQ), (bf16_t*)(ws + WS_S + S_RK), (bf16_t*)(ws + WS_S + S_RV), (const float*)(ws + TAB_COSR), (const float*)(ws + TAB_SINR), row0, (const float*)(ws + WS_RSTD) + row0};
                    _Pragma("unroll") for (int rp = 0; rp < REP_GEMM; ++rp) pg8::gemm_phase<pg8::EpiRetQKV, pg8::StaticOrder, true, true>(Fp.lds, g, S, E, Fp.tid);
                }
                PH_END;
                if (PH_ON && EN_SCAN) { FRESH(); unsigned char* ws = arg_ws(Fp);
                    rscan::pmat_phase(Fp, (const bf16_t*)OBP(O_RQ), (const bf16_t*)(ws + WS_S + S_RK), (bf16_t*)OBP(O_RP), half); }
                PH_END;
                if (PH_ON && EN_SCAN) { FRESH(); unsigned char* ws = arg_ws(Fp);
                    for (int rp = 0; rp < REP_SCAN; ++rp) rscan::scan_phase(Fp, (const bf16_t*)OBP(O_RQ), (const bf16_t*)(ws + WS_S + S_RK), (const bf16_t*)(ws + WS_S + S_RV), (const bf16_t*)OBP(O_RP), (bf16_t*)(ws + WS_S + S_ROF), (bf16_t*)OBP(O_ROB), half); }
                PH_END;
                if (PH_ON && EN_G2) { FRESH();
                    unsigned char* ws = arg_ws(Fp);
                    pg8::Gemm g{(const bf16_t*)(ws + WS_H) + (size_t)row0 * D, (const bf16_t*)(ws + WS_W + W_RG), rows, 4096, D, D, D}; pg8::StaticOrder S; S.init(rows, 4096, F.G, (int)blockIdx.x);
                    pg8::EpiStore<0> E{(bf16_t*)(ws + WS_S + S_RV), 4096, 0, nullptr, (const float*)(ws + WS_RSTD) + row0};
                    _Pragma("unroll") for (int rp = 0; rp < REP_GEMM; ++rp) pg8::gemm_phase<pg8::EpiStore<0>, pg8::StaticOrder, true, true>(Fp.lds, g, S, E, Fp.tid);
                }
                PH_END;
                if (PH_ON && EN_MISC) { FRESH(); unsigned char* ws = arg_ws(Fp); ret_combine_phase(Fp, (const bf16_t*)(ws + WS_S + S_ROF), (const bf16_t*)OBP(O_ROB), (const bf16_t*)(ws + WS_S + S_RV), half ? (bf16_t*)(ws + WS_S + S_ROF) : (bf16_t*)(ws + WS_A), rows); }
                PH_END;
            }
            if (PH_ON && EN_G4) { FRESH();
                for (int hh = 0; hh < 2; ++hh) {
                    unsigned char* ws = arg_ws(Fp); const int rows = hh ? ROWS1 : ROWS0;
                    pg8::Gemm g{hh ? (const bf16_t*)(ws + WS_S + S_ROF) : (const bf16_t*)(ws + WS_A), (const bf16_t*)(ws + WS_W + W_RO), rows, D, 4096, 4096, 4096};
                    pg8::StaticOrder S; S.init(rows, D, F.G, (int)((blockIdx.x + (hh ? 128 : 0)) % F.G));
                    pg8::EpiRes E{(bf16_t*)(ws + WS_H) + (size_t)(hh ? ROWS0 : 0) * D, D, 0, nullptr};
                    pg8::gemm_phase<pg8::EpiRes, pg8::StaticOrder, true, true>(Fp.lds, g, S, E, Fp.tid);
                }
            }
            PH_END;
        } else {
            if (PH_ON && EN_G2) { FRESH();
                unsigned char* ws = arg_ws(Fp);
                pg8::Gemm g{(const bf16_t*)(ws + WS_H), (const bf16_t*)(ws + WS_W + W_MA), MT, MA_N, D, D, D}; pg8::StaticOrder S; S.init(MT, MA_N, F.G, (int)blockIdx.x);
                pg8::EpiStore<0> E{(bf16_t*)OBP(O_MCQKV), MA_N, 0, nullptr, (const float*)(ws + WS_RSTD)};
                _Pragma("unroll") for (int rp = 0; rp < REP_GEMM; ++rp) pg8::gemm_phase<pg8::EpiStore<0>, pg8::StaticOrder, true, true>(Fp.lds, g, S, E, Fp.tid);
            }
            PH_END;
            if (PH_ON && EN_MISC) { FRESH(); unsigned char* ws = arg_ws(Fp); for (int rp = 0; rp < REP_MISC; ++rp) mla_rowpass_phase(Fp, L >> 1, (const bf16_t*)OBP(O_MCQKV), (bf16_t*)(ws + WS_A + X_MCN), (bf16_t*)OBP(O_MKR), MT, 0); }
            PH_END;
            if (PH_ON && EN_G3) { FRESH();
                { unsigned char* ws = arg_ws(Fp);
                  pg8::Gemm g{(const bf16_t*)(ws + WS_A + X_MCN), (const bf16_t*)(ws + WS_W + W_MQB), MT, 3072, 512, 1024, 512}; pg8::StaticOrder S; S.init(MT, 3072, F.G, (int)blockIdx.x);
                  pg8::EpiMlaQ E{(bf16_t*)(ws + WS_S + S_MQ), (const float*)(ws + TAB_COSM), (const float*)(ws + TAB_SINM), 0};
                  _Pragma("unroll") for (int rp = 0; rp < REP_GEMM; ++rp) pg8::gemm_phase<pg8::EpiMlaQ, pg8::StaticOrder, true, true>(Fp.lds, g, S, E, Fp.tid); }
                { unsigned char* ws = arg_ws(Fp);
                  pg8::Gemm g{(const bf16_t*)(ws + WS_A + X_MCN) + 512, (const bf16_t*)(ws + WS_W + W_MKVB), MT, 4096, 512, 1024, 512}; pg8::StaticOrder S; S.init(MT, 4096, F.G, (int)((blockIdx.x + 128) % F.G));
                  pg8::EpiStore<0> E{(bf16_t*)(ws + WS_S + S_MKN), 2048, 2048, (bf16_t*)OBP(O_MV), nullptr};
                  _Pragma("unroll") for (int rp = 0; rp < REP_GEMM; ++rp) pg8::gemm_phase<pg8::EpiStore<0>, pg8::StaticOrder, true, true>(Fp.lds, g, S, E, Fp.tid); }
            }
            PH_END;
            if (PH_ON && EN_ATTN) { FRESH(); unsigned char* ws = arg_ws(Fp);
                for (int rp = 0; rp < REP_ATTN; ++rp) mattn::attn_phase(Fp, (const bf16_t*)(ws + WS_S + S_MQ), (const bf16_t*)(ws + WS_S + S_MKN), (const bf16_t*)OBP(O_MKR), (const bf16_t*)OBP(O_MV), (bf16_t*)(ws + WS_A + X_MO)); }
            PH_END;
            if (PH_ON && EN_G4) { FRESH();
                unsigned char* ws = arg_ws(Fp);
                pg8::Gemm g{(const bf16_t*)(ws + WS_A + X_MO), (const bf16_t*)(ws + WS_W + W_MO), MT, D, D, D, D}; pg8::StaticOrder S; S.init(MT, D, F.G, (int)blockIdx.x);
                _Pragma("unroll") for (int rp = 0; rp < REP_GEMM; ++rp) { pg8::EpiRes E{(bf16_t*)(ws + WS_H), D, rp, nullptr};
                pg8::gemm_phase<pg8::EpiRes, pg8::StaticOrder, true, true>(Fp.lds, g, S, E, Fp.tid); }
            }
            PH_END;
        }
        if (PH_ON && EN_PREP) { FRESH(); for (int rp = 0; rp < REP_MISC; ++rp) norm_phase(Fp, arg_in(Fp, 4) + (size_t)L * D); }
        PH_END;
        if (PH_ON && EN_M1) { FRESH();
            unsigned char* ws = arg_ws(Fp);
            pg8::Gemm g{(const bf16_t*)(ws + WS_A), (const bf16_t*)(ws + WS_W + W_1), MT, FFA, D, D, D}; pg8::StaticOrder S; S.init(MT, FFA, F.G, (int)blockIdx.x);
            pg8::EpiStore<1> E{(bf16_t*)(ws + WS_S + S_HID), FFA, 0, nullptr, nullptr};
            pg8::gemm_phase<pg8::EpiStore<1>, pg8::StaticOrder, true, true>(Fp.lds, g, S, E, Fp.tid);
        }
        PH_END;
        if (PH_ON && EN_M2) { FRESH();
            { unsigned char* ws = arg_ws(Fp);
              pg8::Gemm g{(const bf16_t*)(ws + WS_S + S_HID), (const bf16_t*)(ws + WS_W + W_2), MT, D, FFA, FFA, FF}; pg8::StaticOrder S; S.init(MT, D, F.G, (int)blockIdx.x);
              pg8::EpiRes E{(bf16_t*)(ws + WS_H), D, 0, nullptr};
              pg8::gemm_phase<pg8::EpiRes, pg8::StaticOrder, true, true>(Fp.lds, g, S, E, Fp.tid); }
            { unsigned char* ws = arg_ws(Fp);
              pg8::Gemm g{(const bf16_t*)(ws + WS_A), (const bf16_t*)(ws + WS_W + W_1) + (size_t)FFA * D, MT, FFB, D, D, D}; pg8::UpBOrder S; S.init(MT, FFB, F.G, (int)blockIdx.x);
              pg8::EpiStore<1> E{(bf16_t*)OBP(O_HID), FFB, 0, nullptr, nullptr};
              pg8::gemm_phase<pg8::EpiStore<1>, pg8::UpBOrder, true, true>(Fp.lds, g, S, E, Fp.tid); }
        }
        PH_END;
        if (PH_ON && EN_M2) { FRESH();
            unsigned char* ws = arg_ws(Fp);
            pg8::Gemm g{(const bf16_t*)OBP(O_HID), (const bf16_t*)(ws + WS_W + W_2) + FFA, MT, D, FFB, FFB, FF}; pg8::StaticOrder S; S.init(MT, D, F.G, (int)blockIdx.x);
            pg8::EpiRes E{(bf16_t*)(ws + WS_H), D, 0, (L + 1 < DEPTH) ? (float*)OBP(O_PART) : nullptr};
            pg8::gemm_phase<pg8::EpiRes, pg8::StaticOrder, true, true>(Fp.lds, g, S, E, Fp.tid);
            if (F.G == 256 && L + 1 < DEPTH && blockIdx.x >= 48) { Frame Ff = Fp; Ff.gw = ((int)blockIdx.x - 48) * NWAVES + Fp.wave; Ff.NGW = 208 * NWAVES; convert_phase(Ff, L + 1, 1); }
        }
        PH_END;
    }
    if (PH_ON && EN_PREP) { FRESH(); final_phase(Fp); }
    PH_END;
#undef PH_ON
#undef PH_END
#undef FRESH
#undef WSP
#undef OBP
}

extern "C" void kernel_launch(void* const* d_in, const int* in_sizes, int n_in, void* d_out, int out_size, void* d_ws, size_t ws_size, hipStream_t stream) {
    static int grid = 0;
    if (grid == 0) {
        if (n_in != 20 || ws_size < WS_NEED) { fprintf(stderr, "kernel_launch: n_in %d ws %zu (need %zu)\n", n_in, ws_size, (size_t)WS_NEED); grid = -1; return; }
        int dev = 0, cus = 0, per_cu = 0;
        if (hipGetDevice(&dev) != hipSuccess || hipDeviceGetAttribute(&cus, hipDeviceAttributeMultiprocessorCount, dev) != hipSuccess) { grid = -1; return; }
        if (hipFuncSetAttribute((const void*)mk_fwd, hipFuncAttributeMaxDynamicSharedMemorySize, LDS_BYTES) != hipSuccess) { fprintf(stderr, "kernel_launch: hipFuncSetAttribute failed\n"); grid = -1; return; }
        if (hipOccupancyMaxActiveBlocksPerMultiprocessor(&per_cu, (const void*)mk_fwd, NWAVES * 64, LDS_BYTES) != hipSuccess || per_cu < 1) { fprintf(stderr, "kernel_launch: occupancy query says %d\n", per_cu); }
        (void)hipGetLastError();
        grid = cus;
    }
    if (grid < 0) return;
    (void)hipMemsetAsync((char*)d_ws + WS_CTL, 0, CTL_ZERO_BYTES, stream);
    Args a{};
    for (int i = 0; i < 20; ++i) a.in[i] = (const float*)d_in[i];
    a.out = (float*)d_out; a.ws = (unsigned char*)d_ws;
    for (int j = 0; j < 128; ++j) a.inv_ret[j] = (float)(1.0 / pow(10000.0, (double)(2 * j) / 256.0));
    for (int j = 0; j < 32; ++j) a.inv_mla[j] = (float)(1.0 / pow(10000.0, (double)(2 * j) / 64.0));
    for (int h = 0; h < 8; ++h) { a.lg2[h] = (float)log2(1.0 - pow(2.0, -5.0 - h)); a.lg2[8 + h] = (float)log2(1.0 - pow(2.0, -5.5 - h)); }
#if MK_PER_PHASE_LAUNCH
    for (int p = 0; p < N_PHASES; ++p) { a.ph_lo = p; a.ph_hi = p + 1; hipLaunchKernelGGL(mk_fwd, dim3(grid), dim3(NWAVES * 64), LDS_BYTES, stream, a); }
#else
    a.ph_lo = 0; a.ph_hi = N_PHASES;
    hipLaunchKernelGGL(mk_fwd, dim3(grid), dim3(NWAVES * 64), LDS_BYTES, stream, a);
#endif
    const hipError_t le = hipPeekAtLastError();
    if (le != hipSuccess) fprintf(stderr, "kernel_launch: launch failed: %s\n", hipGetErrorName(le));
}
```
